# Optimizing an MI355X kernel written in HIP

```python
import jax, jax.numpy as jnp
from jax import lax
import numpy as np

D_MODEL = 2048
BATCH = 2
SEQ = 4096
DEPTH = 1

D_CONV = D_MODEL // 2
CONV_GROUPS = 8
CONV_WIDTH = 3
GLA_HEADS = 4
D_GLA_V = D_MODEL // 2
D_GLA_K = D_GLA_V // 2
HEAD_K = D_GLA_K // GLA_HEADS
HEAD_V = D_GLA_V // GLA_HEADS
GATE_RANK = 16
GATE_TAU = 16.0
CHUNK = 64
D_FF = 4 * D_MODEL
LN_EPS = 1e-5
RMS_EPS = 1e-6
DN_ALPHA = (2.0 * DEPTH) ** 0.25
DN_BETA = (8.0 * DEPTH) ** -0.25

PROJ_SIZES = (D_CONV, D_CONV, D_CONV, D_GLA_K, D_GLA_K, D_GLA_V, D_GLA_V, GATE_RANK)
D_IN_PROJ = sum(PROJ_SIZES)
PROJ_SPLITS = tuple(int(s) for s in np.cumsum(PROJ_SIZES)[:-1])

kernel_name = "hymba_conv_gla_deepnorm_block"


def layer_norm(x, g, b):
    xf = x.astype(jnp.float32)
    mu = jnp.mean(xf, axis=-1, keepdims=True)
    var = jnp.mean(jnp.square(xf - mu), axis=-1, keepdims=True)
    y = (xf - mu) * lax.rsqrt(var + LN_EPS)
    return (y * g.astype(jnp.float32) + b.astype(jnp.float32)).astype(x.dtype)


def group_rms_norm(x, g, groups):
    shp = x.shape
    xf = x.astype(jnp.float32).reshape(shp[:-1] + (groups, shp[-1] // groups))
    xf = xf * lax.rsqrt(jnp.mean(jnp.square(xf), axis=-1, keepdims=True) + RMS_EPS)
    return (xf.reshape(shp) * g.astype(jnp.float32)).astype(x.dtype)


def short_gated_conv(b_gate, c_gate, u, conv_w):
    h = c_gate * u
    y = lax.conv_general_dilated(
        h, conv_w[:, None, :].astype(h.dtype), window_strides=(1,),
        padding=[(CONV_WIDTH - 1, 0)], dimension_numbers=("NWC", "WIO", "NWC"),
        feature_group_count=h.shape[-1])
    return b_gate * y


def gla_chunked(q, k, v, log_a):
    bsz, seq = q.shape[0], q.shape[1]
    n_chunks = seq // CHUNK

    def to_chunks(t):
        return t.reshape(bsz, n_chunks, CHUNK, GLA_HEADS, t.shape[-1]).transpose(0, 3, 1, 2, 4).astype(jnp.float32)

    qc = to_chunks(q) * (HEAD_K ** -0.5)
    kc, vc, gc = to_chunks(k), to_chunks(v), to_chunks(log_a)
    bcum = jnp.cumsum(gc, axis=3)
    b_last = bcum[:, :, :, -1:, :]
    q_dec = qc * jnp.exp(bcum)
    k_inv = kc * jnp.exp(-bcum)
    k_end = kc * jnp.exp(b_last - bcum)

    causal = jnp.tril(jnp.ones((CHUNK, CHUNK), dtype=bool))
    scores = jnp.where(causal, jnp.einsum("bhncd,bhnsd->bhncs", q_dec, k_inv), 0.0)
    o_intra = jnp.einsum("bhncs,bhnse->bhnce", scores, vc)

    delta = jnp.einsum("bhncd,bhnce->bhnde", k_end, vc)
    decay = jnp.exp(b_last[:, :, :, 0, :])

    def step(state, inp):
        dec, dlt = inp
        return dec[..., None] * state + dlt, state

    init = jnp.zeros((bsz, GLA_HEADS, HEAD_K, HEAD_V), jnp.float32)
    _, states = lax.scan(step, init, (jnp.moveaxis(decay, 2, 0), jnp.moveaxis(delta, 2, 0)))
    states = jnp.moveaxis(states, 0, 2)
    o_inter = jnp.einsum("bhncd,bhnde->bhnce", q_dec, states)
    o = o_intra + o_inter
    return o.transpose(0, 2, 3, 1, 4).reshape(bsz, seq, GLA_HEADS * HEAD_V)


def setup_inputs(seed: int = 0) -> dict:
    key = jax.random.key(seed)
    ks = jax.random.split(key, 16)
    f32 = jnp.float32
    x = jax.random.normal(ks[0], (BATCH, SEQ, D_MODEL), f32)
    col_scale = jnp.concatenate([
        jnp.full((D_CONV,), 1.0, f32), jnp.full((D_CONV,), 1.0, f32), jnp.full((D_CONV,), DN_BETA, f32),
        jnp.full((D_GLA_K,), 1.0, f32), jnp.full((D_GLA_K,), 1.0, f32), jnp.full((D_GLA_V,), DN_BETA, f32),
        jnp.full((D_GLA_V,), 1.0, f32), jnp.full((GATE_RANK,), 1.0, f32)])
    w_in = jax.random.normal(ks[1], (DEPTH, D_MODEL, D_IN_PROJ), f32) * (D_MODEL ** -0.5) * col_scale
    conv_w = jax.random.normal(ks[2], (DEPTH, CONV_WIDTH, D_CONV), f32) * (CONV_WIDTH ** -0.5)
    conv_norm_g = 1.0 + 0.02 * jax.random.normal(ks[3], (DEPTH, D_CONV), f32)
    w_gate_up = jax.random.normal(ks[4], (DEPTH, GATE_RANK, D_GLA_K), f32) * (GATE_RANK ** -0.5)
    gate_bias = 0.1 * jax.random.normal(ks[5], (DEPTH, D_GLA_K), f32)
    gla_norm_g = 1.0 + 0.02 * jax.random.normal(ks[6], (DEPTH, D_GLA_V), f32)
    w_out = jax.random.normal(ks[7], (DEPTH, D_CONV + D_GLA_V, D_MODEL), f32) * ((D_CONV + D_GLA_V) ** -0.5) * DN_BETA
    ln1_g = 1.0 + 0.02 * jax.random.normal(ks[8], (DEPTH, D_MODEL), f32)
    ln1_b = 0.02 * jax.random.normal(ks[9], (DEPTH, D_MODEL), f32)
    w_ff_up = jax.random.normal(ks[10], (DEPTH, D_MODEL, D_FF), f32) * (D_MODEL ** -0.5) * DN_BETA
    w_ff_down = jax.random.normal(ks[11], (DEPTH, D_FF, D_MODEL), f32) * (D_FF ** -0.5) * DN_BETA
    ln2_g = 1.0 + 0.02 * jax.random.normal(ks[12], (DEPTH, D_MODEL), f32)
    ln2_b = 0.02 * jax.random.normal(ks[13], (DEPTH, D_MODEL), f32)
    return {"x": x, "w_in": w_in, "conv_w": conv_w, "conv_norm_g": conv_norm_g,
            "w_gate_up": w_gate_up, "gate_bias": gate_bias, "gla_norm_g": gla_norm_g,
            "w_out": w_out, "ln1_g": ln1_g, "ln1_b": ln1_b, "w_ff_up": w_ff_up,
            "w_ff_down": w_ff_down, "ln2_g": ln2_g, "ln2_b": ln2_b}


def reference(x, w_in, conv_w, conv_norm_g, w_gate_up, gate_bias, gla_norm_g, w_out,
              ln1_g, ln1_b, w_ff_up, w_ff_down, ln2_g, ln2_b):
    bsz, seq = x.shape[0], x.shape[1]
    for l in range(DEPTH):
        proj = x @ w_in[l]
        b_gate, c_gate, u, q, k, v, r, z_low = jnp.split(proj, PROJ_SPLITS, axis=-1)

        y_conv = short_gated_conv(b_gate, c_gate, u, conv_w[l])
        y_conv = group_rms_norm(y_conv, conv_norm_g[l], CONV_GROUPS)

        z = (z_low @ w_gate_up[l] + gate_bias[l]).astype(jnp.float32)
        log_a = jax.nn.log_sigmoid(z) / GATE_TAU
        hk = (bsz, seq, GLA_HEADS, HEAD_K)
        o = gla_chunked(q.reshape(hk), k.reshape(hk), v.reshape(bsz, seq, GLA_HEADS, HEAD_V), log_a.reshape(hk))
        o = group_rms_norm(o.astype(x.dtype), gla_norm_g[l], GLA_HEADS)
        y_gla = o * jax.nn.silu(r)

        mix = jnp.concatenate([y_conv, y_gla], axis=-1) @ w_out[l]
        x = layer_norm(DN_ALPHA * x + mix, ln1_g[l], ln1_b[l])

        ff = jnp.square(jax.nn.relu(x @ w_ff_up[l])) @ w_ff_down[l]
        x = layer_norm(DN_ALPHA * x + ff, ln2_g[l], ln2_b[l])
    return x
```

```cpp
#include <hip/hip_runtime.h>
#include <hip/hip_cooperative_groups.h>
#include <cstdio>
#include <cstdint>
namespace cg = cooperative_groups;
namespace pg8 {
#define PG8_LAS __attribute__((address_space(3)))
typedef unsigned short bf16_t;
typedef short bf16x8 __attribute__((ext_vector_type(8)));
typedef float f32x4 __attribute__((ext_vector_type(4)));
typedef unsigned u32x4 __attribute__((ext_vector_type(4)));
constexpr int BM = 256, BK = 64, HALF = 128, HTB = HALF * BK * 2  , STAGE_BYTES = 8 * HTB, NXCD = 8, WGM = 8;

__host__ __device__ __forceinline__ int lds_byte(int r, int c) { const int st = (r >> 4) * 2 + (c >> 5), rr = r & 15, cc = c & 31, ob = rr * 64 + cc * 2; return st * 1024 + (ob ^ (((ob >> 9) & 1) << 5)); }
__host__ __device__ __forceinline__ void stage_rc(int b, int& R, int& C) { const int st = b / 1024, sb = b % 1024, swz = sb ^ (((sb >> 9) & 1) << 5); R = (st >> 1) * 16 + swz / 64; C = (st & 1) * 32 + (swz % 64) / 2; }
__host__ __device__ __forceinline__ int perm32(int rho) { const int n = rho >> 4, i = rho & 15; return 8 * (i >> 2) + 4 * n + (i & 3); }

struct Unit { int pm, pn; };
struct Gemm { const bf16_t* A; const bf16_t* Bt; int M, N, K; };

struct StaticOrder {
    int nM, nN, nwg, G, c;
    __host__ __device__ void init(int M, int N, int G_, int c_) { nM = M / BM; nN = N / BM; nwg = nM * nN; G = G_; c = c_; }
    __host__ __device__ bool next(int i, Unit& u) const {
        const long L = (long)i * G + c; if (L >= nwg) return false;
        int wgid = (int)L; { const int q = nwg / NXCD, r = nwg % NXCD, xcd = wgid % NXCD, off = wgid / NXCD; wgid = (xcd < r ? xcd * (q + 1) : r * (q + 1) + (xcd - r) * q) + off; }
        const int nig = WGM * nN, gid = wgid / nig, fm = gid * WGM, gsz = (nM - fm) < WGM ? (nM - fm) : WGM;
        u.pm = fm + ((wgid % nig) % gsz); u.pn = (wgid % nig) / gsz; return true;
    }
    __device__ __forceinline__ void a_ready(const Unit&) const {}
    __device__ __forceinline__ void done(const Unit&) const {}
};

typedef float f32x2_cv __attribute__((ext_vector_type(2)));
typedef __bf16 bf16x2_cv __attribute__((ext_vector_type(2)));
__device__ __forceinline__ unsigned cvt_pk_bf16(float lo, float hi) { const f32x2_cv v = {lo, hi}; const bf16x2_cv b = __builtin_convertvector(v, bf16x2_cv); return __builtin_bit_cast(unsigned, b); }

template <int ACT> struct EpiBf16 {
    static constexpr bool PERM = true, AFTER_DRAIN = false;
    bf16_t* O; int ldc;
    __device__ __forceinline__ void operator()(const f32x4 (&acc)[2][2][4][2], const Unit& u, int wr, int wc, int fr, int fq) const {
        const int row0 = u.pm * BM + wr * 64 + fr, col0 = u.pn * BM + wc * 32 + 8 * fq;
#pragma unroll
        for (int ai = 0; ai < 2; ++ai)
#pragma unroll
            for (int m = 0; m < 4; ++m) { bf16_t* rowp = O + (size_t)(row0 + ai * HALF + m * 16) * ldc + col0;
#pragma unroll
                for (int bj = 0; bj < 2; ++bj) { f32x4 v0 = acc[ai][bj][m][0], v1 = acc[ai][bj][m][1];
                    if (ACT == 1) {
#pragma unroll
                        for (int e = 0; e < 4; ++e) { const float a = fmaxf(v0[e], 0.f), b = fmaxf(v1[e], 0.f); v0[e] = a * a; v1[e] = b * b; } }
                    u32x4 w; w.x = cvt_pk_bf16(v0[0], v0[1]); w.y = cvt_pk_bf16(v0[2], v0[3]); w.z = cvt_pk_bf16(v1[0], v1[1]); w.w = cvt_pk_bf16(v1[2], v1[3]);
                    *(u32x4*)(rowp + bj * HALF) = w; } }
    }
};
struct EpiResF32 {
    static constexpr bool PERM = false, AFTER_DRAIN = false;
    const float* R; float* C; int ldc; float alpha;
    __device__ __forceinline__ void operator()(const f32x4 (&acc)[2][2][4][2], const Unit& u, int wr, int wc, int fr, int fq) const {
        const int row0 = u.pm * BM + wr * 64 + fr, col0 = u.pn * BM + wc * 32 + 4 * fq;
#pragma unroll
        for (int ai = 0; ai < 2; ++ai)
#pragma unroll
            for (int m = 0; m < 4; ++m) { const size_t off = (size_t)(row0 + ai * HALF + m * 16) * ldc + col0;
#pragma unroll
                for (int bj = 0; bj < 2; ++bj)
#pragma unroll
                    for (int n = 0; n < 2; ++n) { const f32x4 r = *(const f32x4*)(R + off + bj * HALF + n * 16);
                        *(f32x4*)(C + off + bj * HALF + n * 16) = acc[ai][bj][m][n] + r * alpha; } }
    }
};
template <class Epi, class Sched, bool ALIGN_EPI = false, bool SP2 = false>
__device__ __forceinline__ void gemm_phase(PG8_LAS unsigned char* lds, const Gemm g, const Sched& S, const Epi& E) {
    const int tid = threadIdx.x, wid = __builtin_amdgcn_readfirstlane(tid >> 6), lane = tid & 63, wr = wid >> 2, wc = wid & 3, fr = lane & 15, fq = lane >> 4;
    const int K = g.K, nt = K / BK;
    unsigned voffA[2], voffB[2];
#pragma unroll
    for (int i = 0; i < 2; ++i) { int R, C; stage_rc(tid * 16 + i * 8192, R, C); const int Rb = Epi::PERM ? ((R & ~31) + perm32(R & 31)) : R;
        voffA[i] = (unsigned)(R * K + C) * 2u; voffB[i] = (unsigned)(Rb * K + C) * 2u; }
    const size_t kstep = (size_t)(BK * 2);
    const size_t hstep = (size_t)HALF * K * 2;
    const size_t tstep = 2 * hstep;
    const unsigned ldsw = (unsigned)wid * 1024u;
    const int aoff = lds_byte(wr * 64 + fr, fq * 8), boff = lds_byte(wc * 32 + fr, fq * 8);
#define PG8_SA(b, h) (((b) * 2 + (h)) * HTB)
#define PG8_SB(b, h) ((4 + (b) * 2 + (h)) * HTB)
#define PG8_STAGE(bufoff, gbase, voff) do { _Pragma("unroll") for (int _i = 0; _i < 2; ++_i) \
        __builtin_amdgcn_global_load_lds((const unsigned*)((const char*)(gbase) + (voff)[_i]), (PG8_LAS unsigned*)(lds + (bufoff) + ldsw + _i * 8192), 16, 0, 0); } while (0)
#define PG8_LDA(dst, b, h) do { _Pragma("unroll") for (int m = 0; m < 4; ++m) _Pragma("unroll") for (int k = 0; k < 2; ++k) dst[m][k] = *(const PG8_LAS bf16x8*)(lds + PG8_SA(b, h) + aoff + m * 2048 + k * 1024); } while (0)
#define PG8_LDB(dst, b, h) do { _Pragma("unroll") for (int n = 0; n < 2; ++n) _Pragma("unroll") for (int k = 0; k < 2; ++k) dst[n][k] = *(const PG8_LAS bf16x8*)(lds + PG8_SB(b, h) + boff + n * 2048 + k * 1024); } while (0)
#define PG8_MMA(ai, bj, At, Bt) do { __builtin_amdgcn_s_setprio(1); _Pragma("unroll") for (int m = 0; m < 4; ++m) _Pragma("unroll") for (int n = 0; n < 2; ++n) _Pragma("unroll") for (int k = 0; k < 2; ++k) \
        acc[ai][bj][m][n] = __builtin_amdgcn_mfma_f32_16x16x32_bf16(Bt[n][k], At[m][k], acc[ai][bj][m][n], 0, 0, 0); __builtin_amdgcn_s_setprio(0); } while (0)
#define PG8_WAIT_V(n) asm volatile("s_waitcnt vmcnt(" #n ")" ::: "memory")
#define PG8_WAIT_L(n) asm volatile("s_waitcnt lgkmcnt(" #n ")" ::: "memory")
#define PG8_BAR __builtin_amdgcn_s_barrier()
#define PG8_SCHED __builtin_amdgcn_sched_barrier(0)
    Unit cur, nxt; int ui = 0;
    if (!S.next(0, cur)) return;
    f32x4 acc[2][2][4][2];
#pragma unroll
    for (int a = 0; a < 2; ++a)
#pragma unroll
        for (int b = 0; b < 2; ++b)
#pragma unroll
            for (int m = 0; m < 4; ++m)
#pragma unroll
                for (int n = 0; n < 2; ++n) acc[a][b][m][n] = (f32x4){0.f, 0.f, 0.f, 0.f};
    bf16x8 At[4][2], B0[2][2], B1[2][2];
    const char* cA = (const char*)g.A + (size_t)cur.pm * tstep; const char* cB = (const char*)g.Bt + (size_t)cur.pn * tstep;
    S.a_ready(cur);
    if constexpr (SP2) {
        PG8_STAGE(PG8_SB(0, 0), cB, voffB); PG8_STAGE(PG8_SB(0, 1), cB + hstep, voffB); PG8_STAGE(PG8_SA(0, 0), cA, voffA); PG8_STAGE(PG8_SA(0, 1), cA + hstep, voffA);
        if (wr == 1) PG8_BAR;
        PG8_WAIT_V(2); PG8_BAR;
        PG8_STAGE(PG8_SB(1, 0), cB + kstep, voffB); PG8_STAGE(PG8_SA(1, 0), cA + kstep, voffA); PG8_STAGE(PG8_SB(1, 1), cB + hstep + kstep, voffB);
        PG8_WAIT_V(6); PG8_BAR;
    } else {
        PG8_STAGE(PG8_SB(0, 0), cB, voffB); PG8_STAGE(PG8_SA(0, 0), cA, voffA); PG8_STAGE(PG8_SB(0, 1), cB + hstep, voffB); PG8_STAGE(PG8_SA(0, 1), cA + hstep, voffA);
        if (wr == 1) PG8_BAR;
        PG8_WAIT_V(4); PG8_BAR;
        PG8_STAGE(PG8_SB(1, 0), cB + kstep, voffB); PG8_STAGE(PG8_SA(1, 0), cA + kstep, voffA); PG8_STAGE(PG8_SB(1, 1), cB + hstep + kstep, voffB);
        PG8_WAIT_V(6); PG8_BAR;
    }
    for (;;) {
        const bool has_next = S.next(ui + 1, nxt);
        const char* nA = has_next ? (const char*)g.A + (size_t)nxt.pm * tstep : cA; const char* nB = has_next ? (const char*)g.Bt + (size_t)nxt.pn * tstep : cB;
        for (int t = 0; t < nt; t += 2) {
            const bool last = (t == nt - 2);
            const char* a1 = cA + (size_t)(t + 1) * kstep;
            const char* a2 = last ? nA : cA + (size_t)(t + 2) * kstep; const char* b2 = last ? nB : cB + (size_t)(t + 2) * kstep;
            const char* a3 = a2 + kstep; const char* b3 = b2 + kstep;
            if (last && has_next) S.a_ready(nxt);
            if constexpr (SP2) {
            PG8_LDB(B0, 0, 0); PG8_LDB(B1, 0, 1); PG8_SCHED; PG8_LDA(At, 0, 0); PG8_STAGE(PG8_SA(1, 1), a1 + hstep, voffA);
            PG8_WAIT_V(8); PG8_WAIT_L(0); PG8_BAR; PG8_MMA(0, 0, At, B0); PG8_MMA(0, 1, At, B1); PG8_BAR; PG8_SCHED;
            PG8_LDA(At, 0, 1); PG8_STAGE(PG8_SB(0, 0), b2, voffB); PG8_STAGE(PG8_SB(0, 1), b2 + hstep, voffB); PG8_STAGE(PG8_SA(0, 0), a2, voffA);
            PG8_WAIT_V(8); PG8_WAIT_L(0); PG8_BAR; PG8_MMA(1, 0, At, B0); PG8_MMA(1, 1, At, B1); PG8_BAR; PG8_SCHED;
            PG8_LDB(B0, 1, 0); PG8_LDB(B1, 1, 1); PG8_SCHED; PG8_LDA(At, 1, 0); PG8_STAGE(PG8_SA(0, 1), a2 + hstep, voffA);
            PG8_WAIT_V(8); PG8_WAIT_L(0); PG8_BAR; PG8_MMA(0, 0, At, B0); PG8_MMA(0, 1, At, B1); PG8_BAR; PG8_SCHED;
            PG8_LDA(At, 1, 1); PG8_STAGE(PG8_SB(1, 0), b3, voffB); PG8_STAGE(PG8_SB(1, 1), b3 + hstep, voffB); PG8_STAGE(PG8_SA(1, 0), a3, voffA);
            PG8_WAIT_V(8); PG8_WAIT_L(0); PG8_BAR; PG8_MMA(1, 0, At, B0); PG8_MMA(1, 1, At, B1); PG8_BAR; PG8_SCHED;
            } else {
            PG8_LDB(B0, 0, 0); PG8_SCHED; PG8_LDA(At, 0, 0); PG8_STAGE(PG8_SA(1, 1), a1 + hstep, voffA);
            PG8_WAIT_L(8); PG8_BAR; PG8_WAIT_L(0); PG8_MMA(0, 0, At, B0); PG8_BAR; PG8_SCHED;
            PG8_LDB(B1, 0, 1); PG8_STAGE(PG8_SB(0, 0), b2, voffB);
            PG8_BAR; PG8_WAIT_L(0); PG8_MMA(0, 1, At, B1); PG8_BAR;
            PG8_LDA(At, 0, 1); PG8_STAGE(PG8_SA(0, 0), a2, voffA);
            PG8_BAR; PG8_WAIT_L(0); PG8_MMA(1, 0, At, B0); PG8_BAR; PG8_SCHED;
            PG8_STAGE(PG8_SB(0, 1), b2 + hstep, voffB);
            PG8_WAIT_V(6); PG8_BAR; PG8_MMA(1, 1, At, B1); PG8_BAR;
            PG8_LDB(B0, 1, 0); PG8_SCHED; PG8_LDA(At, 1, 0); PG8_STAGE(PG8_SA(0, 1), a2 + hstep, voffA);
            PG8_WAIT_L(8); PG8_BAR; PG8_WAIT_L(0); PG8_MMA(0, 0, At, B0); PG8_BAR; PG8_SCHED;
            PG8_LDB(B1, 1, 1); PG8_STAGE(PG8_SB(1, 0), b3, voffB);
            PG8_BAR; PG8_WAIT_L(0); PG8_MMA(0, 1, At, B1); PG8_BAR;
            PG8_LDA(At, 1, 1); PG8_STAGE(PG8_SA(1, 0), a3, voffA);
            PG8_BAR; PG8_WAIT_L(0); PG8_MMA(1, 0, At, B0); PG8_BAR; PG8_SCHED;
            PG8_STAGE(PG8_SB(1, 1), b3 + hstep, voffB);
            PG8_WAIT_V(6); PG8_BAR; PG8_MMA(1, 1, At, B1); PG8_BAR;
            }
        }
        if constexpr (ALIGN_EPI) { if (wr == 0) PG8_BAR; }
        if constexpr (!Epi::AFTER_DRAIN) { E(acc, cur, wr, wc, fr, fq); S.done(cur); }
        if (!has_next) break;
#pragma unroll
        for (int a = 0; a < 2; ++a)
#pragma unroll
            for (int b = 0; b < 2; ++b)
#pragma unroll
                for (int m = 0; m < 4; ++m)
#pragma unroll
                    for (int n = 0; n < 2; ++n) acc[a][b][m][n] = (f32x4){0.f, 0.f, 0.f, 0.f};
        cur = nxt; cA = nA; cB = nB; ++ui;
        if constexpr (ALIGN_EPI) { if (wr == 1) PG8_BAR; }
    }
    PG8_WAIT_V(0);
    if constexpr (!ALIGN_EPI) { if (wr == 0) PG8_BAR; }
    PG8_BAR;
    if constexpr (Epi::AFTER_DRAIN) { E.fused(acc, cur, wr, wc, fr, fq, lds, wid, lane); S.done(cur); }
#undef PG8_SA
#undef PG8_SB
#undef PG8_STAGE
#undef PG8_LDA
#undef PG8_LDB
#undef PG8_MMA
#undef PG8_WAIT_V
#undef PG8_WAIT_L
#undef PG8_BAR
#undef PG8_SCHED
}
}

#define PG8_SP2 true
#define PG8_ALIGN true
constexpr int NWAVES = 8, NTHREADS = 512;
constexpr int BATCH = 2, SEQ = 4096, M = BATCH * SEQ, D = 2048, DFF = 8192;
constexpr int DCONV = 1024, HK = 128, HV = 256, NH = 4, CH = 64, NCHUNK = SEQ / CH;
constexpr int NIN = 6160, NP = 6144;
constexpr int C_B = 0, C_C = 1024, C_U = 2048, C_Q = 3072, C_K = 3584, C_V = 4096, C_R = 5120, C_Z = 6144;
constexpr int NITEM = BATCH * NH * NCHUNK;
constexpr float LN_EPS = 1e-5f, RMS_EPS = 1e-6f;
constexpr float DN_ALPHA = 1.189207115002721f;
constexpr float QSCALE = 0.08838834764831845f;
constexpr size_t MiB = 1u << 20;
constexpr size_t WS_WDN = 0, WS_WUP = 32 * MiB, WS_WOUT = 64 * MiB, WS_WIN = 72 * MiB, WS_XBF = 96 * MiB, WS_PROJ = 128 * MiB;
constexpr size_t WS_ZLOW = 224 * MiB, WS_DECAY = WS_ZLOW + 512 * 1024, WS_END = WS_DECAY + 256 * 1024;
constexpr size_t WS_YMIX = 72 * MiB;
constexpr size_t WS_H = 64 * MiB;
constexpr size_t WS_X1BF = 192 * MiB;
constexpr int LDS_BYTES = 147456;

#define GAS __attribute__((address_space(1)))
#define LAS __attribute__((address_space(3)))
typedef unsigned short bf16;
typedef unsigned v4u __attribute__((ext_vector_type(4)));
typedef unsigned v2u __attribute__((ext_vector_type(2)));
typedef float f32x4 __attribute__((ext_vector_type(4)));
typedef float f32x2 __attribute__((ext_vector_type(2)));
typedef short bf16x8 __attribute__((ext_vector_type(8)));
#define LDS_WAIT() asm volatile("s_waitcnt lgkmcnt(0)" ::: "memory")
__device__ __forceinline__ unsigned pk2(float lo, float hi) { return pg8::cvt_pk_bf16(lo, hi); }
__device__ __forceinline__ float bflo(unsigned u) { return __uint_as_float(u << 16); }
__device__ __forceinline__ float bfhi(unsigned u) { return __uint_as_float(u & 0xffff0000u); }
__device__ __forceinline__ bf16x8 as_frag(v4u v) { return __builtin_bit_cast(bf16x8, v); }
__device__ __forceinline__ f32x4 mfma16(bf16x8 a, bf16x8 b, f32x4 c) { return __builtin_amdgcn_mfma_f32_16x16x32_bf16(a, b, c, 0, 0, 0); }
__device__ __forceinline__ float wave_sum(float v) {
#pragma unroll
    for (int o = 1; o < 64; o <<= 1) v += __shfl_xor(v, o);
    return v;
}

struct Args { const float* in[14]; float* out; unsigned char* ws; };

struct Frame {
    LAS unsigned char* lds;
    int tid, lane, wave, G, gw, NGW;
};

__device__ __forceinline__ void p0_transpose_item(const float* W, int ldw, int nblk, int K, bf16* WT, LAS float* scr, int item, int lane) {
    const int kb = item / nblk, nb = item % nblk, k0 = 64 * kb, n0 = 32 * nb;
#pragma unroll 8
    for (int i = 0; i < 32; ++i) { const int kk = 2 * i + (lane >> 5); scr[kk * 33 + (lane & 31)] = W[(size_t)(k0 + kk) * ldw + n0 + (lane & 31)]; }
    LDS_WAIT(); asm volatile("" ::: "memory");
    const int c = lane & 7;
#pragma unroll
    for (int j = 0; j < 4; ++j) { const int n = (lane >> 3) + 8 * j; const LAS float* s = scr + (8 * c) * 33 + n;
        v4u o; o.x = pk2(s[0 * 33], s[1 * 33]); o.y = pk2(s[2 * 33], s[3 * 33]); o.z = pk2(s[4 * 33], s[5 * 33]); o.w = pk2(s[6 * 33], s[7 * 33]);
        *(v4u*)(WT + (size_t)(n0 + n) * K + k0 + 8 * c) = o; }
    LDS_WAIT(); asm volatile("" ::: "memory");
}
__device__ __forceinline__ void p0_prologue(const Frame& F, const Args& A) {
    unsigned char* ws = A.ws;
    const float* x = A.in[0]; const float* w_in = A.in[1]; const float* w_out = A.in[7]; const float* w_up = A.in[10]; const float* w_dn = A.in[11];
    bf16* WinT = (bf16*)(ws + WS_WIN); bf16* WoutT = (bf16*)(ws + WS_WOUT); bf16* WupT = (bf16*)(ws + WS_WUP); bf16* WdnT = (bf16*)(ws + WS_WDN);
    bf16* xbf = (bf16*)(ws + WS_XBF); float* zlow = (float*)(ws + WS_ZLOW);
    LAS float* scr = (LAS float*)(F.lds + F.wave * 16384);
    constexpr int I_IN = (D / 64) * (NP / 32), I_OUT = (D / 64) * (D / 32), I_UP = (D / 64) * (DFF / 32), I_DN = (DFF / 64) * (D / 32);
    constexpr int NITEMS = I_IN + I_OUT + I_UP + I_DN;
    for (int it = F.gw; it < NITEMS; it += F.NGW) {
        int r = it;
        if (r < I_IN) { p0_transpose_item(w_in, NIN, NP / 32, D, WinT, scr, r, F.lane); continue; } r -= I_IN;
        if (r < I_OUT) { p0_transpose_item(w_out, D, D / 32, D, WoutT, scr, r, F.lane); continue; } r -= I_OUT;
        if (r < I_UP) { p0_transpose_item(w_up, DFF, DFF / 32, D, WupT, scr, r, F.lane); continue; } r -= I_UP;
        p0_transpose_item(w_dn, D, D / 32, DFF, WdnT, scr, r, F.lane);
    }
    __syncthreads();
    const int fr = F.lane & 15, fq = F.lane >> 4;
    LAS float* red = (LAS float*)F.lds;
    for (int rt = blockIdx.x; rt < M / 32; rt += F.G) {
        f32x4 acc0 = {0.f, 0.f, 0.f, 0.f}, acc1 = {0.f, 0.f, 0.f, 0.f};
#pragma unroll 2
        for (int ks = 0; ks < 8; ++ks) {
            const int k0 = F.wave * 256 + ks * 32 + fq * 8;
            float wv[8];
#pragma unroll
            for (int j = 0; j < 8; ++j) wv[j] = w_in[(size_t)(k0 + j) * NIN + C_Z + fr];
            v4u bw; bw.x = pk2(wv[0], wv[1]); bw.y = pk2(wv[2], wv[3]); bw.z = pk2(wv[4], wv[5]); bw.w = pk2(wv[6], wv[7]);
#pragma unroll
            for (int tile = 0; tile < 2; ++tile) {
                const size_t off = (size_t)(rt * 32 + tile * 16 + fr) * D + k0;
                const f32x4 a = *(const f32x4*)(x + off), b = *(const f32x4*)(x + off + 4);
                v4u aw; aw.x = pk2(a.x, a.y); aw.y = pk2(a.z, a.w); aw.z = pk2(b.x, b.y); aw.w = pk2(b.z, b.w);
                *(v4u*)(xbf + off) = aw;
                if (tile == 0) acc0 = mfma16(as_frag(aw), as_frag(bw), acc0); else acc1 = mfma16(as_frag(aw), as_frag(bw), acc1);
            }
        }
#pragma unroll
        for (int j = 0; j < 4; ++j) { red[(F.wave * 2 + 0) * 256 + (fq * 4 + j) * 16 + fr] = acc0[j]; red[(F.wave * 2 + 1) * 256 + (fq * 4 + j) * 16 + fr] = acc1[j]; }
        __syncthreads();
        { const int tile = F.tid >> 8, idx = F.tid & 255; float s = 0.f;
#pragma unroll
          for (int w = 0; w < 8; ++w) s += red[(w * 2 + tile) * 256 + idx];
          zlow[(size_t)(rt * 32 + tile * 16 + (idx >> 4)) * 16 + (idx & 15)] = s; }
        __syncthreads();
    }
}

constexpr int LP = 72;
constexpr int L_VT = 0, L_KT = L_VT + HV * LP * 2, L_SEG = L_KT + HK * LP * 2, L_SC = L_SEG + 8 * HK * 4, L_PART = L_SC + NWAVES * 16 * LP * 2, L_END2 = L_PART + 8 * 16 * 4;
static_assert(L_END2 <= 131072, "mixer LDS");
__device__ __forceinline__ float logsigmoidf(float z) { return fminf(z, 0.f) - log1pf(__expf(-fabsf(z))); }

__device__ __forceinline__ void stage_vT(const Frame& F, const bf16* proj, size_t t0, int h) {
    LAS bf16* vT = (LAS bf16*)(F.lds + L_VT);
#pragma unroll
    for (int i = 0; i < 4; ++i) { const int c = F.tid + NTHREADS * i, t = c & 63, ech = c >> 6;
        const v4u v8 = *(const v4u*)(proj + (t0 + t) * NP + C_V + h * HV + ech * 8);
        LAS bf16* dst = vT + (ech * 8) * LP + t;
        dst[0 * LP] = (bf16)(v8.x & 0xffffu); dst[1 * LP] = (bf16)(v8.x >> 16); dst[2 * LP] = (bf16)(v8.y & 0xffffu); dst[3 * LP] = (bf16)(v8.y >> 16);
        dst[4 * LP] = (bf16)(v8.z & 0xffffu); dst[5 * LP] = (bf16)(v8.z >> 16); dst[6 * LP] = (bf16)(v8.w & 0xffffu); dst[7 * LP] = (bf16)(v8.w >> 16); }
}

__device__ __forceinline__ void p2a_gla(const Frame& F, const Args& A) {
    bf16* proj = (bf16*)(A.ws + WS_PROJ); const float* zlow = (const float*)(A.ws + WS_ZLOW); float* decay = (float*)(A.ws + WS_DECAY);
    const float* wgu = A.in[4]; const float* gbias = A.in[5]; float* ST = A.out;
    LAS bf16* vT = (LAS bf16*)(F.lds + L_VT); LAS bf16* kT = (LAS bf16*)(F.lds + L_KT); LAS float* seg = (LAS float*)(F.lds + L_SEG);
    const int fr = F.lane & 15, fq = F.lane >> 4;
    for (int item = blockIdx.x; item < NITEM; item += F.G) {
        const int bh = item >> 6, n = item & 63, b = bh >> 2, h = bh & 3;
        const size_t t0 = (size_t)b * SEQ + (size_t)n * CH;
        const int d = 2 * F.lane, tq = F.wave;
        float c0[8], c1[8];
        {
            float wg0[16], wg1[16];
#pragma unroll
            for (int j = 0; j < 16; ++j) { const f32x2 w = *(const f32x2*)(wgu + j * 512 + h * HK + d); wg0[j] = w.x; wg1[j] = w.y; }
            const f32x2 bia = *(const f32x2*)(gbias + h * HK + d);
            float run0 = 0.f, run1 = 0.f;
#pragma unroll
            for (int tt = 0; tt < 8; ++tt) {
                const float* zp = zlow + (t0 + tq * 8 + tt) * 16;
                float z0 = bia.x, z1 = bia.y;
#pragma unroll
                for (int j4 = 0; j4 < 4; ++j4) { const f32x4 zl = *(const f32x4*)(zp + 4 * j4);
                    z0 += zl.x * wg0[4 * j4] + zl.y * wg0[4 * j4 + 1] + zl.z * wg0[4 * j4 + 2] + zl.w * wg0[4 * j4 + 3];
                    z1 += zl.x * wg1[4 * j4] + zl.y * wg1[4 * j4 + 1] + zl.z * wg1[4 * j4 + 2] + zl.w * wg1[4 * j4 + 3]; }
                run0 += logsigmoidf(z0) * (1.f / 16.f); run1 += logsigmoidf(z1) * (1.f / 16.f);
                c0[tt] = run0; c1[tt] = run1;
            }
            seg[tq * HK + d] = run0; seg[tq * HK + d + 1] = run1;
        }
        stage_vT(F, proj, t0, h);
        __syncthreads();
        {
            float off0 = 0.f, off1 = 0.f, tot0 = 0.f, tot1 = 0.f;
#pragma unroll
            for (int s = 0; s < 8; ++s) { const float a = seg[s * HK + d], bq = seg[s * HK + d + 1]; tot0 += a; tot1 += bq; if (s < tq) { off0 += a; off1 += bq; } }
            unsigned ke0[4], ke1[4]; float p0 = 0.f, p1 = 0.f;
#pragma unroll
            for (int tt = 0; tt < 8; ++tt) {
                const size_t row = (t0 + tq * 8 + tt) * NP;
                unsigned* qp = (unsigned*)(proj + row + C_Q + h * HK + d); unsigned* kp = (unsigned*)(proj + row + C_K + h * HK + d);
                const unsigned q2 = *qp, k2 = *kp;
                const float b0 = c0[tt] + off0, b1 = c1[tt] + off1;
                const float e0 = __expf(b0), e1 = __expf(b1), i0 = __expf(-b0), i1 = __expf(-b1), f0 = __expf(tot0 - b0), f1 = __expf(tot1 - b1);
                const float k0v = bflo(k2), k1v = bfhi(k2);
                *qp = pk2(bflo(q2) * QSCALE * e0, bfhi(q2) * QSCALE * e1);
                *kp = pk2(k0v * i0, k1v * i1);
                const float g0 = k0v * f0, g1 = k1v * f1;
                if (tt & 1) { ke0[tt >> 1] = pk2(p0, g0); ke1[tt >> 1] = pk2(p1, g1); } else { p0 = g0; p1 = g1; }
            }
            *(LAS v4u*)(kT + d * LP + tq * 8) = (v4u){ke0[0], ke0[1], ke0[2], ke0[3]};
            *(LAS v4u*)(kT + (d + 1) * LP + tq * 8) = (v4u){ke1[0], ke1[1], ke1[2], ke1[3]};
            if (tq == 0) *(f32x2*)(decay + (size_t)item * HK + d) = (f32x2){__expf(tot0), __expf(tot1)};
        }
        __syncthreads();
        float* STi = ST + (size_t)item * (HV * HK);
#pragma unroll
        for (int e2 = 0; e2 < 2; ++e2) {
            const int et = 2 * F.wave + e2;
            const bf16x8 b0 = *(const LAS bf16x8*)(vT + (16 * et + fr) * LP + fq * 8), b1 = *(const LAS bf16x8*)(vT + (16 * et + fr) * LP + 32 + fq * 8);
#pragma unroll
            for (int mt = 0; mt < 8; ++mt) {
                const bf16x8 a0 = *(const LAS bf16x8*)(kT + (16 * mt + fr) * LP + fq * 8), a1 = *(const LAS bf16x8*)(kT + (16 * mt + fr) * LP + 32 + fq * 8);
                f32x4 acc = {0.f, 0.f, 0.f, 0.f};
                acc = mfma16(a0, b0, acc); acc = mfma16(a1, b1, acc);
                *(f32x4*)(STi + (size_t)(16 * et + fr) * HK + 16 * mt + 4 * fq) = acc;
            }
        }
        __syncthreads();
    }
}

__device__ __forceinline__ void p2a_conv(const Frame& F, const Args& A) {
    const bf16* proj = (const bf16*)(A.ws + WS_PROJ); bf16* ymix = (bf16*)(A.ws + WS_YMIX);
    const float* cw = A.in[2]; const float* cg_ = A.in[3];
    for (int wi = F.gw; wi < M / 8; wi += F.NGW) {
        const int tb = wi * 8; const bool has_prev = (tb & (SEQ - 1)) != 0;
#pragma unroll 1
        for (int p = 0; p < 2; ++p) {
            const int ch = p * 512 + F.lane * 8;
            float w0[8], w1[8], w2[8], g[8], hm2[8], hm1[8];
#pragma unroll
            for (int q = 0; q < 2; ++q) { const f32x4 a = *(const f32x4*)(cw + ch + 4 * q), bq = *(const f32x4*)(cw + DCONV + ch + 4 * q), c = *(const f32x4*)(cw + 2 * DCONV + ch + 4 * q), gg = *(const f32x4*)(cg_ + ch + 4 * q);
#pragma unroll
                for (int e = 0; e < 4; ++e) { w0[4 * q + e] = a[e]; w1[4 * q + e] = bq[e]; w2[4 * q + e] = c[e]; g[4 * q + e] = gg[e]; } }
#pragma unroll
            for (int e = 0; e < 8; ++e) { hm2[e] = 0.f; hm1[e] = 0.f; }
            if (has_prev) {
                const v4u c2 = *(const v4u*)(proj + (size_t)(tb - 2) * NP + C_C + ch), u2 = *(const v4u*)(proj + (size_t)(tb - 2) * NP + C_U + ch);
                const v4u c1 = *(const v4u*)(proj + (size_t)(tb - 1) * NP + C_C + ch), u1 = *(const v4u*)(proj + (size_t)(tb - 1) * NP + C_U + ch);
#pragma unroll
                for (int q = 0; q < 4; ++q) { hm2[2 * q] = bflo(c2[q]) * bflo(u2[q]); hm2[2 * q + 1] = bfhi(c2[q]) * bfhi(u2[q]); hm1[2 * q] = bflo(c1[q]) * bflo(u1[q]); hm1[2 * q + 1] = bfhi(c1[q]) * bfhi(u1[q]); }
            }
#pragma unroll 2
            for (int tt = 0; tt < 8; ++tt) {
                const size_t row = (size_t)(tb + tt) * NP;
                const v4u bb = *(const v4u*)(proj + row + C_B + ch), cc = *(const v4u*)(proj + row + C_C + ch), uu = *(const v4u*)(proj + row + C_U + ch);
                float y[8], h0[8], ss = 0.f;
#pragma unroll
                for (int q = 0; q < 4; ++q) { h0[2 * q] = bflo(cc[q]) * bflo(uu[q]); h0[2 * q + 1] = bfhi(cc[q]) * bfhi(uu[q]); }
#pragma unroll
                for (int e = 0; e < 8; ++e) { const float bg = (e & 1) ? bfhi(bb[e >> 1]) : bflo(bb[e >> 1]);
                    y[e] = bg * (w0[e] * hm2[e] + w1[e] * hm1[e] + w2[e] * h0[e]); ss += y[e] * y[e]; hm2[e] = hm1[e]; hm1[e] = h0[e]; }
                ss += __shfl_xor(ss, 1); ss += __shfl_xor(ss, 2); ss += __shfl_xor(ss, 4); ss += __shfl_xor(ss, 8);
                const float rstd = rsqrtf(ss * (1.f / 128.f) + RMS_EPS);
                v4u o; o.x = pk2(y[0] * rstd * g[0], y[1] * rstd * g[1]); o.y = pk2(y[2] * rstd * g[2], y[3] * rstd * g[3]); o.z = pk2(y[4] * rstd * g[4], y[5] * rstd * g[5]); o.w = pk2(y[6] * rstd * g[6], y[7] * rstd * g[7]);
                *(v4u*)(ymix + (size_t)(tb + tt) * D + ch) = o;
            }
        }
    }
}

__device__ __forceinline__ void p2b_scan(const Frame& F, const Args& A) {
    float* ST = A.out; const float* decay = (const float*)(A.ws + WS_DECAY);
    constexpr int PER_BH = HV * HK / 2;
    for (int g = blockIdx.x * NTHREADS + F.tid; g < BATCH * NH * PER_BH; g += F.G * NTHREADS) {
        const int bh = g / PER_BH, rem = g % PER_BH, d = (rem & 63) * 2;
        float* p = ST + (size_t)bh * NCHUNK * (HV * HK) + (size_t)rem * 2; const float* dc = decay + (size_t)bh * NCHUNK * HK + d;
        f32x2 S = {0.f, 0.f};
#pragma unroll 8
        for (int n = 0; n < NCHUNK; ++n) {
            const f32x2 dl = *(const f32x2*)(p + (size_t)n * (HV * HK)); const f32x2 dcv = *(const f32x2*)(dc + n * HK);
            *(f32x2*)(p + (size_t)n * (HV * HK)) = S;
            S = dcv * S + dl;
        }
    }
}

__device__ __forceinline__ void p2c_gla(const Frame& F, const Args& A) {
    const bf16* proj = (const bf16*)(A.ws + WS_PROJ); bf16* ymix = (bf16*)(A.ws + WS_YMIX); const float* ST = A.out; const float* gng = A.in[6];
    LAS bf16* vT = (LAS bf16*)(F.lds + L_VT); LAS bf16* sc = (LAS bf16*)(F.lds + L_SC) + F.wave * 16 * LP; LAS float* part = (LAS float*)(F.lds + L_PART);
    const int fr = F.lane & 15, fq = F.lane >> 4, mt = F.wave & 3, eh = F.wave >> 2;
    for (int item = blockIdx.x; item < NITEM; item += F.G) {
        const int bh = item >> 6, n = item & 63, b = bh >> 2, h = bh & 3;
        const size_t t0 = (size_t)b * SEQ + (size_t)n * CH;
        stage_vT(F, proj, t0, h);
        const size_t qrow = (t0 + 16 * mt + fr) * NP;
        bf16x8 qf[4];
#pragma unroll
        for (int kk = 0; kk < 4; ++kk) qf[kk] = *(const bf16x8*)(proj + qrow + C_Q + h * HK + kk * 32 + fq * 8);
#pragma unroll
        for (int st = 0; st < 4; ++st) {
            f32x4 acc = {0.f, 0.f, 0.f, 0.f};
            if (st <= mt) {
                const size_t krow = (t0 + 16 * st + fr) * NP + C_K + h * HK + fq * 8;
#pragma unroll
                for (int kk = 0; kk < 4; ++kk) { const bf16x8 kf = *(const bf16x8*)(proj + krow + kk * 32); acc = mfma16(kf, qf[kk], acc); }
                if (st == mt) {
#pragma unroll
                    for (int j = 0; j < 4; ++j) if (fq * 4 + j > fr) acc[j] = 0.f;
                }
            }
            *(LAS v2u*)(sc + fr * LP + 16 * st + fq * 4) = (v2u){pk2(acc[0], acc[1]), pk2(acc[2], acc[3])};
        }
        __syncthreads();
        const bf16x8 y0 = *(const LAS bf16x8*)(sc + fr * LP + fq * 8), y1 = *(const LAS bf16x8*)(sc + fr * LP + 32 + fq * 8);
        const float* STi = ST + (size_t)item * (HV * HK);
        f32x4 o[8]; float ss = 0.f;
#pragma unroll
        for (int et = 0; et < 8; ++et) {
            const int e0 = 128 * eh + 16 * et;
            f32x4 acc = {0.f, 0.f, 0.f, 0.f};
            const bf16x8 v0 = *(const LAS bf16x8*)(vT + (e0 + fr) * LP + fq * 8);
            acc = mfma16(v0, y0, acc);
            if (mt >= 2) { const bf16x8 v1 = *(const LAS bf16x8*)(vT + (e0 + fr) * LP + 32 + fq * 8); acc = mfma16(v1, y1, acc); }
            const float* sp = STi + (size_t)(e0 + fr) * HK + fq * 8;
#pragma unroll
            for (int kk = 0; kk < 4; ++kk) { const f32x4 s0 = *(const f32x4*)(sp + kk * 32), s1 = *(const f32x4*)(sp + kk * 32 + 4);
                v4u sw; sw.x = pk2(s0.x, s0.y); sw.y = pk2(s0.z, s0.w); sw.z = pk2(s1.x, s1.y); sw.w = pk2(s1.z, s1.w);
                acc = mfma16(as_frag(sw), qf[kk], acc); }
            o[et] = acc;
            ss += acc[0] * acc[0] + acc[1] * acc[1] + acc[2] * acc[2] + acc[3] * acc[3];
        }
        ss += __shfl_xor(ss, 16); ss += __shfl_xor(ss, 32);
        if (fq == 0) part[F.wave * 16 + fr] = ss;
        __syncthreads();
        const float tot = part[F.wave * 16 + fr] + part[(F.wave ^ 4) * 16 + fr];
        const float rstd = rsqrtf(tot * (1.f / HV) + RMS_EPS);
        const size_t trow = t0 + 16 * mt + fr;
#pragma unroll
        for (int et = 0; et < 8; ++et) {
            const int e = 128 * eh + 16 * et + 4 * fq;
            const f32x4 g4 = *(const f32x4*)(gng + h * HV + e);
            const v2u r2 = *(const v2u*)(proj + trow * NP + C_R + h * HV + e);
            const float r[4] = {bflo(r2.x), bfhi(r2.x), bflo(r2.y), bfhi(r2.y)};
            float yv[4];
#pragma unroll
            for (int j = 0; j < 4; ++j) yv[j] = o[et][j] * rstd * g4[j] * (r[j] / (1.f + __expf(-r[j])));
            *(v2u*)(ymix + trow * D + DCONV + h * HV + e) = (v2u){pk2(yv[0], yv[1]), pk2(yv[2], yv[3])};
        }
        __syncthreads();
    }
}

template <bool WITH_BF16>
__device__ __forceinline__ void ln_phase(const Frame& F, float* X, const float* g, const float* bta, bf16* XB) {
    for (int m = F.gw; m < M; m += F.NGW) {
        f32x4* xr = (f32x4*)(X + (size_t)m * D) + F.lane;
        f32x4 v[8]; float s = 0.f;
#pragma unroll
        for (int j = 0; j < 8; ++j) { v[j] = xr[64 * j]; s += (v[j].x + v[j].y) + (v[j].z + v[j].w); }
        const float mean = wave_sum(s) * (1.f / D); float s2 = 0.f;
#pragma unroll
        for (int j = 0; j < 8; ++j) { v[j] = v[j] - mean; s2 += (v[j].x * v[j].x + v[j].y * v[j].y) + (v[j].z * v[j].z + v[j].w * v[j].w); }
        const float rstd = rsqrtf(wave_sum(s2) * (1.f / D) + LN_EPS);
#pragma unroll
        for (int j = 0; j < 8; ++j) { const f32x4 gg = *((const f32x4*)g + F.lane + 64 * j), bb = *((const f32x4*)bta + F.lane + 64 * j);
            const f32x4 y = v[j] * rstd * gg + bb; xr[64 * j] = y;
            if (WITH_BF16) *((v2u*)(XB + (size_t)m * D) + F.lane + 64 * j) = (v2u){pk2(y.x, y.y), pk2(y.z, y.w)}; }
    }
}

__global__ void __launch_bounds__(NTHREADS, 2) hymba_fwd(Args args) {
    extern __shared__ __attribute__((aligned(16))) unsigned char lds[];
    cg::grid_group grid = cg::this_grid();
    Frame F;
    F.lds = (LAS unsigned char*)lds;
    F.tid = threadIdx.x; F.lane = F.tid & 63; F.wave = __builtin_amdgcn_readfirstlane(F.tid >> 6);
    F.G = gridDim.x; F.gw = blockIdx.x * NWAVES + F.wave; F.NGW = F.G * NWAVES;
    unsigned char* ws = args.ws;
    bf16* proj = (bf16*)(ws + WS_PROJ); bf16* ymix = (bf16*)(ws + WS_YMIX); bf16* x1bf = (bf16*)(ws + WS_X1BF); bf16* hb = (bf16*)(ws + WS_H);

#define GRID_SYNC() do { __builtin_amdgcn_fence(__ATOMIC_RELEASE, "agent"); asm volatile("s_waitcnt vmcnt(0)" ::: "memory"); grid.sync(); \
        __builtin_amdgcn_fence(__ATOMIC_ACQUIRE, "agent"); asm volatile("s_waitcnt vmcnt(0)" ::: "memory"); __syncthreads(); } while (0)
    p0_prologue(F, args);
    GRID_SYNC();
    {
        pg8::Gemm g{(const bf16*)(ws + WS_XBF), (const bf16*)(ws + WS_WIN), M, NP, D}; pg8::StaticOrder S; S.init(M, NP, F.G, (int)blockIdx.x);
        pg8::EpiBf16<0> E{proj, NP};
        pg8::gemm_phase<pg8::EpiBf16<0>, pg8::StaticOrder, PG8_ALIGN, PG8_SP2>(F.lds, g, S, E);
    }
    GRID_SYNC();
    p2a_gla(F, args);
    p2a_conv(F, args);
    GRID_SYNC();
    p2b_scan(F, args);
    GRID_SYNC();
    p2c_gla(F, args);
    GRID_SYNC();
    {
        pg8::Gemm g{ymix, (const bf16*)(ws + WS_WOUT), M, D, D}; pg8::StaticOrder S; S.init(M, D, F.G, (int)blockIdx.x);
        pg8::EpiResF32 E{args.in[0], args.out, D, DN_ALPHA};
        pg8::gemm_phase<pg8::EpiResF32, pg8::StaticOrder, PG8_ALIGN, PG8_SP2>(F.lds, g, S, E);
    }
    GRID_SYNC();
    ln_phase<true>(F, args.out, args.in[8], args.in[9], x1bf);
    GRID_SYNC();
    {
        pg8::Gemm g{x1bf, (const bf16*)(ws + WS_WUP), M, DFF, D}; pg8::StaticOrder S; S.init(M, DFF, F.G, (int)blockIdx.x);
        pg8::EpiBf16<1> E{hb, DFF};
        pg8::gemm_phase<pg8::EpiBf16<1>, pg8::StaticOrder, PG8_ALIGN, PG8_SP2>(F.lds, g, S, E);
    }
    GRID_SYNC();
    {
        pg8::Gemm g{hb, (const bf16*)(ws + WS_WDN), M, D, DFF}; pg8::StaticOrder S; S.init(M, D, F.G, (int)blockIdx.x);
        pg8::EpiResF32 E{args.out, args.out, D, DN_ALPHA};
        pg8::gemm_phase<pg8::EpiResF32, pg8::StaticOrder, PG8_ALIGN, PG8_SP2>(F.lds, g, S, E);
    }
    GRID_SYNC();
    ln_phase<false>(F, args.out, args.in[12], args.in[13], nullptr);
}

extern "C" void kernel_launch(void* const* d_in, const int* in_sizes, int n_in, void* d_out, int out_size, void* d_ws, size_t ws_size, hipStream_t stream) {
    static int grid = 0;
    if (grid == 0) {
        if (n_in != 14 || in_sizes[0] != M * D || out_size != M * D || ws_size < WS_END) { fprintf(stderr, "kernel_launch: unexpected shapes (n_in %d, in0 %d, out %d, ws %zu); nothing launched\n", n_in, n_in > 0 ? in_sizes[0] : -1, out_size, ws_size); grid = -1; return; }
        int dev = 0, cus = 0, per_cu = 0;
        if (hipGetDevice(&dev) != hipSuccess || hipDeviceGetAttribute(&cus, hipDeviceAttributeMultiprocessorCount, dev) != hipSuccess) { grid = -1; return; }
        if (hipFuncSetAttribute((const void*)hymba_fwd, hipFuncAttributeMaxDynamicSharedMemorySize, LDS_BYTES) != hipSuccess) { fprintf(stderr, "kernel_launch: hipFuncSetAttribute failed\n"); grid = -1; return; }
        if (hipOccupancyMaxActiveBlocksPerMultiprocessor(&per_cu, (const void*)hymba_fwd, NTHREADS, LDS_BYTES) != hipSuccess || per_cu < 1) { fprintf(stderr, "kernel_launch: occupancy query says %d blocks per CU\n", per_cu); per_cu = 1; }
        (void)hipGetLastError();
        grid = cus * per_cu;
    }
    if (grid < 0) return;
    Args a{};
    for (int i = 0; i < 14; ++i) a.in[i] = (const float*)d_in[i];
    a.out = (float*)d_out; a.ws = (unsigned char*)d_ws;
    void* kargs[] = {&a};
    const hipError_t e = hipLaunchCooperativeKernel((const void*)hymba_fwd, dim3(grid), dim3(NTHREADS), kargs, LDS_BYTES, stream);
    if (e != hipSuccess) fprintf(stderr, "kernel_launch: cooperative launch failed: %s (grid %d)\n", hipGetErrorString(e), grid);
}
```

```cpp
#include <hip/hip_runtime.h>
#include <hip/hip_cooperative_groups.h>
#include <cstdio>
#include <cstdint>
namespace cg = cooperative_groups;
namespace pg8 {
#define PG8_LAS __attribute__((address_space(3)))
typedef unsigned short bf16_t;
typedef short bf16x8 __attribute__((ext_vector_type(8)));
typedef float f32x4 __attribute__((ext_vector_type(4)));
typedef unsigned u32x4 __attribute__((ext_vector_type(4)));
constexpr int BM = 256, BK = 64, HALF = 128, HTB = HALF * BK * 2  , STAGE_BYTES = 8 * HTB, NXCD = 8, WGM = 8;

__host__ __device__ __forceinline__ int lds_byte(int r, int c) { const int st = (r >> 4) * 2 + (c >> 5), rr = r & 15, cc = c & 31, ob = rr * 64 + cc * 2; return st * 1024 + (ob ^ (((ob >> 9) & 1) << 5)); }
__host__ __device__ __forceinline__ void stage_rc(int b, int& R, int& C) { const int st = b / 1024, sb = b % 1024, swz = sb ^ (((sb >> 9) & 1) << 5); R = (st >> 1) * 16 + swz / 64; C = (st & 1) * 32 + (swz % 64) / 2; }
__host__ __device__ __forceinline__ int perm32(int rho) { const int n = rho >> 4, i = rho & 15; return 8 * (i >> 2) + 4 * n + (i & 3); }

struct Unit { int pm, pn; };
struct Gemm { const bf16_t* A; const bf16_t* Bt; int M, N, K; };

struct StaticOrder {
    int nM, nN, nwg, G, c;
    __host__ __device__ void init(int M, int N, int G_, int c_) { nM = M / BM; nN = N / BM; nwg = nM * nN; G = G_; c = c_; }
    __host__ __device__ bool next(int i, Unit& u) const {
        const long L = (long)i * G + c; if (L >= nwg) return false;
        int wgid = (int)L; { const int q = nwg / NXCD, r = nwg % NXCD, xcd = wgid % NXCD, off = wgid / NXCD; wgid = (xcd < r ? xcd * (q + 1) : r * (q + 1) + (xcd - r) * q) + off; }
        const int nig = WGM * nN, gid = wgid / nig, fm = gid * WGM, gsz = (nM - fm) < WGM ? (nM - fm) : WGM;
        u.pm = fm + ((wgid % nig) % gsz); u.pn = (wgid % nig) / gsz; return true;
    }
    __device__ __forceinline__ void a_ready(const Unit&) const {}
    __device__ __forceinline__ void done(const Unit&) const {}
};

typedef float f32x2_cv __attribute__((ext_vector_type(2)));
typedef __bf16 bf16x2_cv __attribute__((ext_vector_type(2)));
__device__ __forceinline__ unsigned cvt_pk_bf16(float lo, float hi) { const f32x2_cv v = {lo, hi}; const bf16x2_cv b = __builtin_convertvector(v, bf16x2_cv); return __builtin_bit_cast(unsigned, b); }

template <int ACT> struct EpiBf16 {
    static constexpr bool PERM = true, AFTER_DRAIN = false;
    bf16_t* O; int ldc;
    __device__ __forceinline__ void operator()(const f32x4 (&acc)[2][2][4][2], const Unit& u, int wr, int wc, int fr, int fq) const {
        const int row0 = u.pm * BM + wr * 64 + fr, col0 = u.pn * BM + wc * 32 + 8 * fq;
#pragma unroll
        for (int ai = 0; ai < 2; ++ai)
#pragma unroll
            for (int m = 0; m < 4; ++m) { bf16_t* rowp = O + (size_t)(row0 + ai * HALF + m * 16) * ldc + col0;
#pragma unroll
                for (int bj = 0; bj < 2; ++bj) { f32x4 v0 = acc[ai][bj][m][0], v1 = acc[ai][bj][m][1];
                    if (ACT == 1) {
#pragma unroll
                        for (int e = 0; e < 4; ++e) { const float a = fmaxf(v0[e], 0.f), b = fmaxf(v1[e], 0.f); v0[e] = a * a; v1[e] = b * b; } }
                    u32x4 w; w.x = cvt_pk_bf16(v0[0], v0[1]); w.y = cvt_pk_bf16(v0[2], v0[3]); w.z = cvt_pk_bf16(v1[0], v1[1]); w.w = cvt_pk_bf16(v1[2], v1[3]);
                    *(u32x4*)(rowp + bj * HALF) = w; } }
    }
};
struct EpiResF32 {
    static constexpr bool PERM = false, AFTER_DRAIN = false;
    const float* R; float* C; int ldc; float alpha;
    __device__ __forceinline__ void operator()(const f32x4 (&acc)[2][2][4][2], const Unit& u, int wr, int wc, int fr, int fq) const {
        const int row0 = u.pm * BM + wr * 64 + fr, col0 = u.pn * BM + wc * 32 + 4 * fq;
#pragma unroll
        for (int ai = 0; ai < 2; ++ai)
#pragma unroll
            for (int m = 0; m < 4; ++m) { const size_t off = (size_t)(row0 + ai * HALF + m * 16) * ldc + col0;
#pragma unroll
                for (int bj = 0; bj < 2; ++bj)
#pragma unroll
                    for (int n = 0; n < 2; ++n) { const f32x4 r = *(const f32x4*)(R + off + bj * HALF + n * 16);
                        *(f32x4*)(C + off + bj * HALF + n * 16) = acc[ai][bj][m][n] + r * alpha; } }
    }
};
template <class Epi, class Sched, bool ALIGN_EPI = false, bool SP2 = false>
__device__ __forceinline__ void gemm_phase(PG8_LAS unsigned char* lds, const Gemm g, const Sched& S, const Epi& E) {
    const int tid = threadIdx.x, wid = __builtin_amdgcn_readfirstlane(tid >> 6), lane = tid & 63, wr = wid >> 2, wc = wid & 3, fr = lane & 15, fq = lane >> 4;
    const int K = g.K, nt = K / BK;
    unsigned voffA[2], voffB[2];
#pragma unroll
    for (int i = 0; i < 2; ++i) { int R, C; stage_rc(tid * 16 + i * 8192, R, C); const int Rb = Epi::PERM ? ((R & ~31) + perm32(R & 31)) : R;
        voffA[i] = (unsigned)(R * K + C) * 2u; voffB[i] = (unsigned)(Rb * K + C) * 2u; }
    const size_t kstep = (size_t)(BK * 2);
    const size_t hstep = (size_t)HALF * K * 2;
    const size_t tstep = 2 * hstep;
    const unsigned ldsw = (unsigned)wid * 1024u;
    const int aoff = lds_byte(wr * 64 + fr, fq * 8), boff = lds_byte(wc * 32 + fr, fq * 8);
#define PG8_SA(b, h) (((b) * 2 + (h)) * HTB)
#define PG8_SB(b, h) ((4 + (b) * 2 + (h)) * HTB)
#define PG8_STAGE(bufoff, gbase, voff) do { _Pragma("unroll") for (int _i = 0; _i < 2; ++_i) \
        __builtin_amdgcn_global_load_lds((const unsigned*)((const char*)(gbase) + (voff)[_i]), (PG8_LAS unsigned*)(lds + (bufoff) + ldsw + _i * 8192), 16, 0, 0); } while (0)
#define PG8_LDA(dst, b, h) do { _Pragma("unroll") for (int m = 0; m < 4; ++m) _Pragma("unroll") for (int k = 0; k < 2; ++k) dst[m][k] = *(const PG8_LAS bf16x8*)(lds + PG8_SA(b, h) + aoff + m * 2048 + k * 1024); } while (0)
#define PG8_LDB(dst, b, h) do { _Pragma("unroll") for (int n = 0; n < 2; ++n) _Pragma("unroll") for (int k = 0; k < 2; ++k) dst[n][k] = *(const PG8_LAS bf16x8*)(lds + PG8_SB(b, h) + boff + n * 2048 + k * 1024); } while (0)
#define PG8_MMA(ai, bj, At, Bt) do { __builtin_amdgcn_s_setprio(1); _Pragma("unroll") for (int m = 0; m < 4; ++m) _Pragma("unroll") for (int n = 0; n < 2; ++n) _Pragma("unroll") for (int k = 0; k < 2; ++k) \
        acc[ai][bj][m][n] = __builtin_amdgcn_mfma_f32_16x16x32_bf16(Bt[n][k], At[m][k], acc[ai][bj][m][n], 0, 0, 0); __builtin_amdgcn_s_setprio(0); } while (0)
#define PG8_WAIT_V(n) asm volatile("s_waitcnt vmcnt(" #n ")" ::: "memory")
#define PG8_WAIT_L(n) asm volatile("s_waitcnt lgkmcnt(" #n ")" ::: "memory")
#define PG8_BAR __builtin_amdgcn_s_barrier()
#define PG8_SCHED __builtin_amdgcn_sched_barrier(0)
    Unit cur, nxt; int ui = 0;
    if (!S.next(0, cur)) return;
    f32x4 acc[2][2][4][2];
#pragma unroll
    for (int a = 0; a < 2; ++a)
#pragma unroll
        for (int b = 0; b < 2; ++b)
#pragma unroll
            for (int m = 0; m < 4; ++m)
#pragma unroll
                for (int n = 0; n < 2; ++n) acc[a][b][m][n] = (f32x4){0.f, 0.f, 0.f, 0.f};
    bf16x8 At[4][2], B0[2][2], B1[2][2];
    const char* cA = (const char*)g.A + (size_t)cur.pm * tstep; const char* cB = (const char*)g.Bt + (size_t)cur.pn * tstep;
    S.a_ready(cur);
    if constexpr (SP2) {
        PG8_STAGE(PG8_SB(0, 0), cB, voffB); PG8_STAGE(PG8_SB(0, 1), cB + hstep, voffB); PG8_STAGE(PG8_SA(0, 0), cA, voffA); PG8_STAGE(PG8_SA(0, 1), cA + hstep, voffA);
        if (wr == 1) PG8_BAR;
        PG8_WAIT_V(2); PG8_BAR;
        PG8_STAGE(PG8_SB(1, 0), cB + kstep, voffB); PG8_STAGE(PG8_SA(1, 0), cA + kstep, voffA); PG8_STAGE(PG8_SB(1, 1), cB + hstep + kstep, voffB);
        PG8_WAIT_V(6); PG8_BAR;
    } else {
        PG8_STAGE(PG8_SB(0, 0), cB, voffB); PG8_STAGE(PG8_SA(0, 0), cA, voffA); PG8_STAGE(PG8_SB(0, 1), cB + hstep, voffB); PG8_STAGE(PG8_SA(0, 1), cA + hstep, voffA);
        if (wr == 1) PG8_BAR;
        PG8_WAIT_V(4); PG8_BAR;
        PG8_STAGE(PG8_SB(1, 0), cB + kstep, voffB); PG8_STAGE(PG8_SA(1, 0), cA + kstep, voffA); PG8_STAGE(PG8_SB(1, 1), cB + hstep + kstep, voffB);
        PG8_WAIT_V(6); PG8_BAR;
    }
    for (;;) {
        const bool has_next = S.next(ui + 1, nxt);
        const char* nA = has_next ? (const char*)g.A + (size_t)nxt.pm * tstep : cA; const char* nB = has_next ? (const char*)g.Bt + (size_t)nxt.pn * tstep : cB;
        for (int t = 0; t < nt; t += 2) {
            const bool last = (t == nt - 2);
            const char* a1 = cA + (size_t)(t + 1) * kstep;
            const char* a2 = last ? nA : cA + (size_t)(t + 2) * kstep; const char* b2 = last ? nB : cB + (size_t)(t + 2) * kstep;
            const char* a3 = a2 + kstep; const char* b3 = b2 + kstep;
            if (last && has_next) S.a_ready(nxt);
            if constexpr (SP2) {
            PG8_LDB(B0, 0, 0); PG8_LDB(B1, 0, 1); PG8_SCHED; PG8_LDA(At, 0, 0); PG8_STAGE(PG8_SA(1, 1), a1 + hstep, voffA);
            PG8_WAIT_V(8); PG8_WAIT_L(0); PG8_BAR; PG8_MMA(0, 0, At, B0); PG8_MMA(0, 1, At, B1); PG8_BAR; PG8_SCHED;
            PG8_LDA(At, 0, 1); PG8_STAGE(PG8_SB(0, 0), b2, voffB); PG8_STAGE(PG8_SB(0, 1), b2 + hstep, voffB); PG8_STAGE(PG8_SA(0, 0), a2, voffA);
            PG8_WAIT_V(8); PG8_WAIT_L(0); PG8_BAR; PG8_MMA(1, 0, At, B0); PG8_MMA(1, 1, At, B1); PG8_BAR; PG8_SCHED;
            PG8_LDB(B0, 1, 0); PG8_LDB(B1, 1, 1); PG8_SCHED; PG8_LDA(At, 1, 0); PG8_STAGE(PG8_SA(0, 1), a2 + hstep, voffA);
            PG8_WAIT_V(8); PG8_WAIT_L(0); PG8_BAR; PG8_MMA(0, 0, At, B0); PG8_MMA(0, 1, At, B1); PG8_BAR; PG8_SCHED;
            PG8_LDA(At, 1, 1); PG8_STAGE(PG8_SB(1, 0), b3, voffB); PG8_STAGE(PG8_SB(1, 1), b3 + hstep, voffB); PG8_STAGE(PG8_SA(1, 0), a3, voffA);
            PG8_WAIT_V(8); PG8_WAIT_L(0); PG8_BAR; PG8_MMA(1, 0, At, B0); PG8_MMA(1, 1, At, B1); PG8_BAR; PG8_SCHED;
            } else {
            PG8_LDB(B0, 0, 0); PG8_SCHED; PG8_LDA(At, 0, 0); PG8_STAGE(PG8_SA(1, 1), a1 + hstep, voffA);
            PG8_WAIT_L(8); PG8_BAR; PG8_WAIT_L(0); PG8_MMA(0, 0, At, B0); PG8_BAR; PG8_SCHED;
            PG8_LDB(B1, 0, 1); PG8_STAGE(PG8_SB(0, 0), b2, voffB);
            PG8_BAR; PG8_WAIT_L(0); PG8_MMA(0, 1, At, B1); PG8_BAR;
            PG8_LDA(At, 0, 1); PG8_STAGE(PG8_SA(0, 0), a2, voffA);
            PG8_BAR; PG8_WAIT_L(0); PG8_MMA(1, 0, At, B0); PG8_BAR; PG8_SCHED;
            PG8_STAGE(PG8_SB(0, 1), b2 + hstep, voffB);
            PG8_WAIT_V(6); PG8_BAR; PG8_MMA(1, 1, At, B1); PG8_BAR;
            PG8_LDB(B0, 1, 0); PG8_SCHED; PG8_LDA(At, 1, 0); PG8_STAGE(PG8_SA(0, 1), a2 + hstep, voffA);
            PG8_WAIT_L(8); PG8_BAR; PG8_WAIT_L(0); PG8_MMA(0, 0, At, B0); PG8_BAR; PG8_SCHED;
            PG8_LDB(B1, 1, 1); PG8_STAGE(PG8_SB(1, 0), b3, voffB);
            PG8_BAR; PG8_WAIT_L(0); PG8_MMA(0, 1, At, B1); PG8_BAR;
            PG8_LDA(At, 1, 1); PG8_STAGE(PG8_SA(1, 0), a3, voffA);
            PG8_BAR; PG8_WAIT_L(0); PG8_MMA(1, 0, At, B0); PG8_BAR; PG8_SCHED;
            PG8_STAGE(PG8_SB(1, 1), b3 + hstep, voffB);
            PG8_WAIT_V(6); PG8_BAR; PG8_MMA(1, 1, At, B1); PG8_BAR;
            }
        }
        if constexpr (ALIGN_EPI) { if (wr == 0) PG8_BAR; }
        if constexpr (!Epi::AFTER_DRAIN) { E(acc, cur, wr, wc, fr, fq); S.done(cur); }
        if (!has_next) break;
#pragma unroll
        for (int a = 0; a < 2; ++a)
#pragma unroll
            for (int b = 0; b < 2; ++b)
#pragma unroll
                for (int m = 0; m < 4; ++m)
#pragma unroll
                    for (int n = 0; n < 2; ++n) acc[a][b][m][n] = (f32x4){0.f, 0.f, 0.f, 0.f};
        cur = nxt; cA = nA; cB = nB; ++ui;
        if constexpr (ALIGN_EPI) { if (wr == 1) PG8_BAR; }
    }
    PG8_WAIT_V(0);
    if constexpr (!ALIGN_EPI) { if (wr == 0) PG8_BAR; }
    PG8_BAR;
    if constexpr (Epi::AFTER_DRAIN) { E.fused(acc, cur, wr, wc, fr, fq, lds, wid, lane); S.done(cur); }
#undef PG8_SA
#undef PG8_SB
#undef PG8_STAGE
#undef PG8_LDA
#undef PG8_LDB
#undef PG8_MMA
#undef PG8_WAIT_V
#undef PG8_WAIT_L
#undef PG8_BAR
#undef PG8_SCHED
}
}

#define PG8_SP2 true
#define PG8_ALIGN true
constexpr int NWAVES = 8, NTHREADS = 512;
constexpr int BATCH = 2, SEQ = 4096, M = BATCH * SEQ, D = 2048, DFF = 8192;
constexpr int DCONV = 1024, HK = 128, HV = 256, NH = 4, CH = 64, NCHUNK = SEQ / CH;
constexpr int NIN = 6160, NP = 6144;
constexpr int C_B = 0, C_C = 1024, C_U = 2048, C_Q = 3072, C_K = 3584, C_V = 4096, C_R = 5120, C_Z = 6144;
constexpr int NITEM = BATCH * NH * NCHUNK;
constexpr float LN_EPS = 1e-5f, RMS_EPS = 1e-6f;
constexpr float DN_ALPHA = 1.189207115002721f;
constexpr float QSCALE = 0.08838834764831845f;
constexpr size_t MiB = 1u << 20;
constexpr size_t WS_WDN = 0, WS_WUP = 32 * MiB, WS_WOUT = 64 * MiB, WS_WIN = 72 * MiB, WS_XBF = 96 * MiB, WS_PROJ = 128 * MiB;
constexpr size_t WS_ZLOW = 224 * MiB, WS_DECAY = WS_ZLOW + 512 * 1024, WS_BAR = WS_DECAY + 256 * 1024, BAR_BYTES = 16384, WS_END = WS_BAR + BAR_BYTES;
constexpr size_t WS_YMIX = 72 * MiB;
constexpr size_t WS_H = 64 * MiB;
constexpr size_t WS_X1BF = 192 * MiB;
constexpr int LDS_BYTES = 147456;
constexpr int MISC_OFF = 131072;

#define GAS __attribute__((address_space(1)))
#define LAS __attribute__((address_space(3)))
typedef unsigned short bf16;
typedef unsigned v4u __attribute__((ext_vector_type(4)));
typedef unsigned v2u __attribute__((ext_vector_type(2)));
typedef float f32x4 __attribute__((ext_vector_type(4)));
typedef float f32x2 __attribute__((ext_vector_type(2)));
typedef short bf16x8 __attribute__((ext_vector_type(8)));
#define LDS_WAIT() asm volatile("s_waitcnt lgkmcnt(0)" ::: "memory")
__device__ __forceinline__ unsigned pk2(float lo, float hi) { return pg8::cvt_pk_bf16(lo, hi); }
__device__ __forceinline__ float bflo(unsigned u) { return __uint_as_float(u << 16); }
__device__ __forceinline__ float bfhi(unsigned u) { return __uint_as_float(u & 0xffff0000u); }
__device__ __forceinline__ bf16x8 as_frag(v4u v) { return __builtin_bit_cast(bf16x8, v); }
__device__ __forceinline__ f32x4 mfma16(bf16x8 a, bf16x8 b, f32x4 c) { return __builtin_amdgcn_mfma_f32_16x16x32_bf16(a, b, c, 0, 0, 0); }
__device__ __forceinline__ float wave_sum(float v) {
#pragma unroll
    for (int o = 1; o < 64; o <<= 1) v += __shfl_xor(v, o);
    return v;
}

typedef GAS unsigned gu32;
#define RLX_AGENT __ATOMIC_RELAXED, __HIP_MEMORY_SCOPE_AGENT
#define XB_TMO      128
#define XB_XCNT(j)  (256  + 64 * (j))
#define XB_XSUB(j)  (1280 + 64 * (j))
#define XB_XGEN(j)  (2304 + 64 * (j))
#define XB_TOP      3328
#define XB_TOPGEN   3392
#define XCD_BAR_WORDS 3456
#define XB_SPIN_CAP (1u << 18)

__device__ __forceinline__ unsigned xb_ld(unsigned* p)              { return __hip_atomic_load(p, __ATOMIC_RELAXED, __HIP_MEMORY_SCOPE_AGENT); }
__device__ __forceinline__ unsigned xb_add(unsigned* p, unsigned v) { return __hip_atomic_fetch_add(p, v, __ATOMIC_RELAXED, __HIP_MEMORY_SCOPE_AGENT); }
__device__ __forceinline__ unsigned xb_xcc_id() { return (unsigned)__builtin_amdgcn_s_getreg((3 << 11) | 20) & 0xFu; }
#define XB_SPIN(cond, bar) do { unsigned _sp = 0; while (cond) { __builtin_amdgcn_s_sleep(1); \
    if ((++_sp & 255u) == 0u) { if (xb_ld(&(bar)[XB_TMO])) break; if (_sp > XB_SPIN_CAP) { atomicAdd(&(bar)[XB_TMO], 1u); break; } } } } while (0)

struct XcdBarrier {
    unsigned* bar; unsigned x;
    volatile LAS unsigned* st;
};

__device__ __forceinline__ XcdBarrier xcd_barrier_post(unsigned* bar, volatile LAS unsigned* st) {
    XcdBarrier b; b.bar = bar; b.x = xb_xcc_id(); b.st = st;
    if (threadIdx.x == 0) (void)xb_add(&bar[XB_XCNT(b.x)], 1u);
    return b;
}
__device__ __forceinline__ void xcd_barrier_complete(unsigned* bar, unsigned x, unsigned& nloc, unsigned& nx) {
    const unsigned G = gridDim.x * gridDim.y * gridDim.z;
    unsigned sum, cnt, mine, sp = 0u;
    for (;;) {
        sum = 0u; cnt = 0u; mine = 0u;
#pragma unroll
        for (unsigned j = 0; j < 16; ++j) { const unsigned c = xb_ld(&bar[XB_XCNT(j)]); sum += c; cnt += (c > 0u) ? 1u : 0u; mine = (j == x) ? c : mine; }
        if (sum == G) break;
        __builtin_amdgcn_s_sleep(1);
        if ((++sp & 255u) == 0u) { if (xb_ld(&bar[XB_TMO])) break; if (sp > XB_SPIN_CAP) { atomicAdd(&bar[XB_TMO], 1u); break; } }
    }
    nloc = mine > 0u ? mine : 1u; nx = cnt > 0u ? cnt : 1u;
}

__device__ __forceinline__ void xcd_barrier(const XcdBarrier& b) {
    asm volatile("s_waitcnt vmcnt(0)" ::: "memory");
    __syncthreads();
    if (threadIdx.x == 0) {
        unsigned* bar = b.bar;
        __builtin_amdgcn_s_waitcnt(0);
        unsigned nloc = b.st[0], nx = b.st[1];
        if (nloc == 0u) { xcd_barrier_complete(bar, b.x, nloc, nx); b.st[0] = nloc; b.st[1] = nx; }
        const unsigned old = xb_add(&bar[XB_XSUB(b.x)], 1u);
        const unsigned gen = old / nloc;
        if (old + 1u == (gen + 1u) * nloc) {
            __builtin_amdgcn_fence(__ATOMIC_RELEASE, "agent");
            asm volatile("s_waitcnt vmcnt(0)" ::: "memory");
            const unsigned og = xb_add(&bar[XB_TOP], 1u);
            const unsigned tg = og / nx;
            if (og + 1u == (tg + 1u) * nx) xb_add(&bar[XB_TOPGEN], 1u);
            else XB_SPIN(xb_ld(&bar[XB_TOPGEN]) == tg, bar);
            __builtin_amdgcn_fence(__ATOMIC_ACQUIRE, "agent");
            xb_add(&bar[XB_XGEN(b.x)], 1u);
            asm volatile("s_waitcnt vmcnt(0)" ::: "memory");
        } else {
            XB_SPIN(xb_ld(&bar[XB_XGEN(b.x)]) == gen, bar);
            __builtin_amdgcn_fence(__ATOMIC_ACQUIRE, "agent");
            asm volatile("s_waitcnt vmcnt(0)" ::: "memory");
        }
    }
    __syncthreads();
}

struct Args { const float* in[14]; float* out; unsigned char* ws; };

struct Frame {
    LAS unsigned char* lds;
    int tid, lane, wave, G, gw, NGW;
};

__device__ __forceinline__ void p0_transpose_item(const float* W, int ldw, int nblk, int K, bf16* WT, LAS float* scr, int item, int lane) {
    const int kb = item / nblk, nb = item % nblk, k0 = 64 * kb, n0 = 32 * nb;
#pragma unroll 8
    for (int i = 0; i < 32; ++i) { const int kk = 2 * i + (lane >> 5); scr[kk * 33 + (lane & 31)] = W[(size_t)(k0 + kk) * ldw + n0 + (lane & 31)]; }
    LDS_WAIT(); asm volatile("" ::: "memory");
    const int c = lane & 7;
#pragma unroll
    for (int j = 0; j < 4; ++j) { const int n = (lane >> 3) + 8 * j; const LAS float* s = scr + (8 * c) * 33 + n;
        v4u o; o.x = pk2(s[0 * 33], s[1 * 33]); o.y = pk2(s[2 * 33], s[3 * 33]); o.z = pk2(s[4 * 33], s[5 * 33]); o.w = pk2(s[6 * 33], s[7 * 33]);
        *(v4u*)(WT + (size_t)(n0 + n) * K + k0 + 8 * c) = o; }
    LDS_WAIT(); asm volatile("" ::: "memory");
}
__device__ __forceinline__ void p0_prologue(const Frame& F, const Args& A) {
    unsigned char* ws = A.ws;
    const float* x = A.in[0]; const float* w_in = A.in[1]; const float* w_out = A.in[7]; const float* w_up = A.in[10]; const float* w_dn = A.in[11];
    bf16* WinT = (bf16*)(ws + WS_WIN); bf16* WoutT = (bf16*)(ws + WS_WOUT); bf16* WupT = (bf16*)(ws + WS_WUP); bf16* WdnT = (bf16*)(ws + WS_WDN);
    bf16* xbf = (bf16*)(ws + WS_XBF); float* zlow = (float*)(ws + WS_ZLOW);
    LAS float* scr = (LAS float*)(F.lds + F.wave * 16384);
    constexpr int I_IN = (D / 64) * (NP / 32), I_OUT = (D / 64) * (D / 32), I_UP = (D / 64) * (DFF / 32), I_DN = (DFF / 64) * (D / 32);
    constexpr int NITEMS = I_IN + I_OUT + I_UP + I_DN;
    for (int it = F.gw; it < NITEMS; it += F.NGW) {
        int r = it;
        if (r < I_IN) { p0_transpose_item(w_in, NIN, NP / 32, D, WinT, scr, r, F.lane); continue; } r -= I_IN;
        if (r < I_OUT) { p0_transpose_item(w_out, D, D / 32, D, WoutT, scr, r, F.lane); continue; } r -= I_OUT;
        if (r < I_UP) { p0_transpose_item(w_up, DFF, DFF / 32, D, WupT, scr, r, F.lane); continue; } r -= I_UP;
        p0_transpose_item(w_dn, D, D / 32, DFF, WdnT, scr, r, F.lane);
    }
    __syncthreads();
    const int fr = F.lane & 15, fq = F.lane >> 4;
    LAS float* red = (LAS float*)F.lds;
    for (int rt = blockIdx.x; rt < M / 32; rt += F.G) {
        f32x4 acc0 = {0.f, 0.f, 0.f, 0.f}, acc1 = {0.f, 0.f, 0.f, 0.f};
#pragma unroll 2
        for (int ks = 0; ks < 8; ++ks) {
            const int k0 = F.wave * 256 + ks * 32 + fq * 8;
            float wv[8];
#pragma unroll
            for (int j = 0; j < 8; ++j) wv[j] = w_in[(size_t)(k0 + j) * NIN + C_Z + fr];
            v4u bw; bw.x = pk2(wv[0], wv[1]); bw.y = pk2(wv[2], wv[3]); bw.z = pk2(wv[4], wv[5]); bw.w = pk2(wv[6], wv[7]);
#pragma unroll
            for (int tile = 0; tile < 2; ++tile) {
                const size_t off = (size_t)(rt * 32 + tile * 16 + fr) * D + k0;
                const f32x4 a = *(const f32x4*)(x + off), b = *(const f32x4*)(x + off + 4);
                v4u aw; aw.x = pk2(a.x, a.y); aw.y = pk2(a.z, a.w); aw.z = pk2(b.x, b.y); aw.w = pk2(b.z, b.w);
                *(v4u*)(xbf + off) = aw;
                if (tile == 0) acc0 = mfma16(as_frag(aw), as_frag(bw), acc0); else acc1 = mfma16(as_frag(aw), as_frag(bw), acc1);
            }
        }
#pragma unroll
        for (int j = 0; j < 4; ++j) { red[(F.wave * 2 + 0) * 256 + (fq * 4 + j) * 16 + fr] = acc0[j]; red[(F.wave * 2 + 1) * 256 + (fq * 4 + j) * 16 + fr] = acc1[j]; }
        __syncthreads();
        { const int tile = F.tid >> 8, idx = F.tid & 255; float s = 0.f;
#pragma unroll
          for (int w = 0; w < 8; ++w) s += red[(w * 2 + tile) * 256 + idx];
          zlow[(size_t)(rt * 32 + tile * 16 + (idx >> 4)) * 16 + (idx & 15)] = s; }
        __syncthreads();
    }
}

constexpr int LP = 72;
constexpr int L_VT = 0, L_KT = L_VT + HV * LP * 2, L_SEG = L_KT + HK * LP * 2, L_SC = L_SEG + 8 * HK * 4, L_PART = L_SC + NWAVES * 16 * LP * 2, L_END2 = L_PART + 8 * 16 * 4;
static_assert(L_END2 <= 131072, "mixer LDS");
__device__ __forceinline__ float logsigmoidf(float z) { return fminf(z, 0.f) - log1pf(__expf(-fabsf(z))); }

__device__ __forceinline__ void stage_vT(const Frame& F, const bf16* proj, size_t t0, int h) {
    LAS bf16* vT = (LAS bf16*)(F.lds + L_VT);
#pragma unroll
    for (int i = 0; i < 4; ++i) { const int c = F.tid + NTHREADS * i, t = c & 63, ech = c >> 6;
        const v4u v8 = *(const v4u*)(proj + (t0 + t) * NP + C_V + h * HV + ech * 8);
        LAS bf16* dst = vT + (ech * 8) * LP + t;
        dst[0 * LP] = (bf16)(v8.x & 0xffffu); dst[1 * LP] = (bf16)(v8.x >> 16); dst[2 * LP] = (bf16)(v8.y & 0xffffu); dst[3 * LP] = (bf16)(v8.y >> 16);
        dst[4 * LP] = (bf16)(v8.z & 0xffffu); dst[5 * LP] = (bf16)(v8.z >> 16); dst[6 * LP] = (bf16)(v8.w & 0xffffu); dst[7 * LP] = (bf16)(v8.w >> 16); }
}

__device__ __forceinline__ void p2a_gla(const Frame& F, const Args& A) {
    bf16* proj = (bf16*)(A.ws + WS_PROJ); const float* zlow = (const float*)(A.ws + WS_ZLOW); float* decay = (float*)(A.ws + WS_DECAY);
    const float* wgu = A.in[4]; const float* gbias = A.in[5]; float* ST = A.out;
    LAS bf16* vT = (LAS bf16*)(F.lds + L_VT); LAS bf16* kT = (LAS bf16*)(F.lds + L_KT); LAS float* seg = (LAS float*)(F.lds + L_SEG);
    const int fr = F.lane & 15, fq = F.lane >> 4;
    for (int item = blockIdx.x; item < NITEM; item += F.G) {
        const int bh = item >> 6, n = item & 63, b = bh >> 2, h = bh & 3;
        const size_t t0 = (size_t)b * SEQ + (size_t)n * CH;
        const int d = 2 * F.lane, tq = F.wave;
        float c0[8], c1[8];
        {
            float wg0[16], wg1[16];
#pragma unroll
            for (int j = 0; j < 16; ++j) { const f32x2 w = *(const f32x2*)(wgu + j * 512 + h * HK + d); wg0[j] = w.x; wg1[j] = w.y; }
            const f32x2 bia = *(const f32x2*)(gbias + h * HK + d);
            float run0 = 0.f, run1 = 0.f;
#pragma unroll
            for (int tt = 0; tt < 8; ++tt) {
                const float* zp = zlow + (t0 + tq * 8 + tt) * 16;
                float z0 = bia.x, z1 = bia.y;
#pragma unroll
                for (int j4 = 0; j4 < 4; ++j4) { const f32x4 zl = *(const f32x4*)(zp + 4 * j4);
                    z0 += zl.x * wg0[4 * j4] + zl.y * wg0[4 * j4 + 1] + zl.z * wg0[4 * j4 + 2] + zl.w * wg0[4 * j4 + 3];
                    z1 += zl.x * wg1[4 * j4] + zl.y * wg1[4 * j4 + 1] + zl.z * wg1[4 * j4 + 2] + zl.w * wg1[4 * j4 + 3]; }
                run0 += logsigmoidf(z0) * (1.f / 16.f); run1 += logsigmoidf(z1) * (1.f / 16.f);
                c0[tt] = run0; c1[tt] = run1;
            }
            seg[tq * HK + d] = run0; seg[tq * HK + d + 1] = run1;
        }
        stage_vT(F, proj, t0, h);
        __syncthreads();
        {
            float off0 = 0.f, off1 = 0.f, tot0 = 0.f, tot1 = 0.f;
#pragma unroll
            for (int s = 0; s < 8; ++s) { const float a = seg[s * HK + d], bq = seg[s * HK + d + 1]; tot0 += a; tot1 += bq; if (s < tq) { off0 += a; off1 += bq; } }
            unsigned ke0[4], ke1[4]; float p0 = 0.f, p1 = 0.f;
#pragma unroll
            for (int tt = 0; tt < 8; ++tt) {
                const size_t row = (t0 + tq * 8 + tt) * NP;
                unsigned* qp = (unsigned*)(proj + row + C_Q + h * HK + d); unsigned* kp = (unsigned*)(proj + row + C_K + h * HK + d);
                const unsigned q2 = *qp, k2 = *kp;
                const float b0 = c0[tt] + off0, b1 = c1[tt] + off1;
                const float e0 = __expf(b0), e1 = __expf(b1), i0 = __expf(-b0), i1 = __expf(-b1), f0 = __expf(tot0 - b0), f1 = __expf(tot1 - b1);
                const float k0v = bflo(k2), k1v = bfhi(k2);
                *qp = pk2(bflo(q2) * QSCALE * e0, bfhi(q2) * QSCALE * e1);
                *kp = pk2(k0v * i0, k1v * i1);
                const float g0 = k0v * f0, g1 = k1v * f1;
                if (tt & 1) { ke0[tt >> 1] = pk2(p0, g0); ke1[tt >> 1] = pk2(p1, g1); } else { p0 = g0; p1 = g1; }
            }
            *(LAS v4u*)(kT + d * LP + tq * 8) = (v4u){ke0[0], ke0[1], ke0[2], ke0[3]};
            *(LAS v4u*)(kT + (d + 1) * LP + tq * 8) = (v4u){ke1[0], ke1[1], ke1[2], ke1[3]};
            if (tq == 0) *(f32x2*)(decay + (size_t)item * HK + d) = (f32x2){__expf(tot0), __expf(tot1)};
        }
        __syncthreads();
        float* STi = ST + (size_t)item * (HV * HK);
#pragma unroll
        for (int e2 = 0; e2 < 2; ++e2) {
            const int et = 2 * F.wave + e2;
            const bf16x8 b0 = *(const LAS bf16x8*)(vT + (16 * et + fr) * LP + fq * 8), b1 = *(const LAS bf16x8*)(vT + (16 * et + fr) * LP + 32 + fq * 8);
#pragma unroll
            for (int mt = 0; mt < 8; ++mt) {
                const bf16x8 a0 = *(const LAS bf16x8*)(kT + (16 * mt + fr) * LP + fq * 8), a1 = *(const LAS bf16x8*)(kT + (16 * mt + fr) * LP + 32 + fq * 8);
                f32x4 acc = {0.f, 0.f, 0.f, 0.f};
                acc = mfma16(a0, b0, acc); acc = mfma16(a1, b1, acc);
                *(f32x4*)(STi + (size_t)(16 * et + fr) * HK + 16 * mt + 4 * fq) = acc;
            }
        }
        __syncthreads();
    }
}

__device__ __forceinline__ void p2a_conv(const Frame& F, const Args& A) {
    const bf16* proj = (const bf16*)(A.ws + WS_PROJ); bf16* ymix = (bf16*)(A.ws + WS_YMIX);
    const float* cw = A.in[2]; const float* cg_ = A.in[3];
    for (int wi = F.gw; wi < M / 8; wi += F.NGW) {
        const int tb = wi * 8; const bool has_prev = (tb & (SEQ - 1)) != 0;
#pragma unroll 1
        for (int p = 0; p < 2; ++p) {
            const int ch = p * 512 + F.lane * 8;
            float w0[8], w1[8], w2[8], g[8], hm2[8], hm1[8];
#pragma unroll
            for (int q = 0; q < 2; ++q) { const f32x4 a = *(const f32x4*)(cw + ch + 4 * q), bq = *(const f32x4*)(cw + DCONV + ch + 4 * q), c = *(const f32x4*)(cw + 2 * DCONV + ch + 4 * q), gg = *(const f32x4*)(cg_ + ch + 4 * q);
#pragma unroll
                for (int e = 0; e < 4; ++e) { w0[4 * q + e] = a[e]; w1[4 * q + e] = bq[e]; w2[4 * q + e] = c[e]; g[4 * q + e] = gg[e]; } }
#pragma unroll
            for (int e = 0; e < 8; ++e) { hm2[e] = 0.f; hm1[e] = 0.f; }
            if (has_prev) {
                const v4u c2 = *(const v4u*)(proj + (size_t)(tb - 2) * NP + C_C + ch), u2 = *(const v4u*)(proj + (size_t)(tb - 2) * NP + C_U + ch);
                const v4u c1 = *(const v4u*)(proj + (size_t)(tb - 1) * NP + C_C + ch), u1 = *(const v4u*)(proj + (size_t)(tb - 1) * NP + C_U + ch);
#pragma unroll
                for (int q = 0; q < 4; ++q) { hm2[2 * q] = bflo(c2[q]) * bflo(u2[q]); hm2[2 * q + 1] = bfhi(c2[q]) * bfhi(u2[q]); hm1[2 * q] = bflo(c1[q]) * bflo(u1[q]); hm1[2 * q + 1] = bfhi(c1[q]) * bfhi(u1[q]); }
            }
#pragma unroll 2
            for (int tt = 0; tt < 8; ++tt) {
                const size_t row = (size_t)(tb + tt) * NP;
                const v4u bb = *(const v4u*)(proj + row + C_B + ch), cc = *(const v4u*)(proj + row + C_C + ch), uu = *(const v4u*)(proj + row + C_U + ch);
                float y[8], h0[8], ss = 0.f;
#pragma unroll
                for (int q = 0; q < 4; ++q) { h0[2 * q] = bflo(cc[q]) * bflo(uu[q]); h0[2 * q + 1] = bfhi(cc[q]) * bfhi(uu[q]); }
#pragma unroll
                for (int e = 0; e < 8; ++e) { const float bg = (e & 1) ? bfhi(bb[e >> 1]) : bflo(bb[e >> 1]);
                    y[e] = bg * (w0[e] * hm2[e] + w1[e] * hm1[e] + w2[e] * h0[e]); ss += y[e] * y[e]; hm2[e] = hm1[e]; hm1[e] = h0[e]; }
                ss += __shfl_xor(ss, 1); ss += __shfl_xor(ss, 2); ss += __shfl_xor(ss, 4); ss += __shfl_xor(ss, 8);
                const float rstd = rsqrtf(ss * (1.f / 128.f) + RMS_EPS);
                v4u o; o.x = pk2(y[0] * rstd * g[0], y[1] * rstd * g[1]); o.y = pk2(y[2] * rstd * g[2], y[3] * rstd * g[3]); o.z = pk2(y[4] * rstd * g[4], y[5] * rstd * g[5]); o.w = pk2(y[6] * rstd * g[6], y[7] * rstd * g[7]);
                *(v4u*)(ymix + (size_t)(tb + tt) * D + ch) = o;
            }
        }
    }
}

__device__ __forceinline__ void p2b_scan(const Frame& F, const Args& A) {
    float* ST = A.out; const float* decay = (const float*)(A.ws + WS_DECAY);
    constexpr int PER_BH = HV * HK / 2;
    for (int g = blockIdx.x * NTHREADS + F.tid; g < BATCH * NH * PER_BH; g += F.G * NTHREADS) {
        const int bh = g / PER_BH, rem = g % PER_BH, d = (rem & 63) * 2;
        float* p = ST + (size_t)bh * NCHUNK * (HV * HK) + (size_t)rem * 2; const float* dc = decay + (size_t)bh * NCHUNK * HK + d;
        f32x2 S = {0.f, 0.f};
#pragma unroll 8
        for (int n = 0; n < NCHUNK; ++n) {
            const f32x2 dl = *(const f32x2*)(p + (size_t)n * (HV * HK)); const f32x2 dcv = *(const f32x2*)(dc + n * HK);
            *(f32x2*)(p + (size_t)n * (HV * HK)) = S;
            S = dcv * S + dl;
        }
    }
}

__device__ __forceinline__ void p2c_gla(const Frame& F, const Args& A) {
    const bf16* proj = (const bf16*)(A.ws + WS_PROJ); bf16* ymix = (bf16*)(A.ws + WS_YMIX); const float* ST = A.out; const float* gng = A.in[6];
    LAS bf16* vT = (LAS bf16*)(F.lds + L_VT); LAS bf16* sc = (LAS bf16*)(F.lds + L_SC) + F.wave * 16 * LP; LAS float* part = (LAS float*)(F.lds + L_PART);
    const int fr = F.lane & 15, fq = F.lane >> 4, mt = F.wave & 3, eh = F.wave >> 2;
    for (int item = blockIdx.x; item < NITEM; item += F.G) {
        const int bh = item >> 6, n = item & 63, b = bh >> 2, h = bh & 3;
        const size_t t0 = (size_t)b * SEQ + (size_t)n * CH;
        stage_vT(F, proj, t0, h);
        const size_t qrow = (t0 + 16 * mt + fr) * NP;
        bf16x8 qf[4];
#pragma unroll
        for (int kk = 0; kk < 4; ++kk) qf[kk] = *(const bf16x8*)(proj + qrow + C_Q + h * HK + kk * 32 + fq * 8);
#pragma unroll
        for (int st = 0; st < 4; ++st) {
            f32x4 acc = {0.f, 0.f, 0.f, 0.f};
            if (st <= mt) {
                const size_t krow = (t0 + 16 * st + fr) * NP + C_K + h * HK + fq * 8;
#pragma unroll
                for (int kk = 0; kk < 4; ++kk) { const bf16x8 kf = *(const bf16x8*)(proj + krow + kk * 32); acc = mfma16(kf, qf[kk], acc); }
                if (st == mt) {
#pragma unroll
                    for (int j = 0; j < 4; ++j) if (fq * 4 + j > fr) acc[j] = 0.f;
                }
            }
            *(LAS v2u*)(sc + fr * LP + 16 * st + fq * 4) = (v2u){pk2(acc[0], acc[1]), pk2(acc[2], acc[3])};
        }
        __syncthreads();
        const bf16x8 y0 = *(const LAS bf16x8*)(sc + fr * LP + fq * 8), y1 = *(const LAS bf16x8*)(sc + fr * LP + 32 + fq * 8);
        const float* STi = ST + (size_t)item * (HV * HK);
        f32x4 o[8]; float ss = 0.f;
#pragma unroll
        for (int et = 0; et < 8; ++et) {
            const int e0 = 128 * eh + 16 * et;
            f32x4 acc = {0.f, 0.f, 0.f, 0.f};
            const bf16x8 v0 = *(const LAS bf16x8*)(vT + (e0 + fr) * LP + fq * 8);
            acc = mfma16(v0, y0, acc);
            if (mt >= 2) { const bf16x8 v1 = *(const LAS bf16x8*)(vT + (e0 + fr) * LP + 32 + fq * 8); acc = mfma16(v1, y1, acc); }
            const float* sp = STi + (size_t)(e0 + fr) * HK + fq * 8;
#pragma unroll
            for (int kk = 0; kk < 4; ++kk) { const f32x4 s0 = *(const f32x4*)(sp + kk * 32), s1 = *(const f32x4*)(sp + kk * 32 + 4);
                v4u sw; sw.x = pk2(s0.x, s0.y); sw.y = pk2(s0.z, s0.w); sw.z = pk2(s1.x, s1.y); sw.w = pk2(s1.z, s1.w);
                acc = mfma16(as_frag(sw), qf[kk], acc); }
            o[et] = acc;
            ss += acc[0] * acc[0] + acc[1] * acc[1] + acc[2] * acc[2] + acc[3] * acc[3];
        }
        ss += __shfl_xor(ss, 16); ss += __shfl_xor(ss, 32);
        if (fq == 0) part[F.wave * 16 + fr] = ss;
        __syncthreads();
        const float tot = part[F.wave * 16 + fr] + part[(F.wave ^ 4) * 16 + fr];
        const float rstd = rsqrtf(tot * (1.f / HV) + RMS_EPS);
        const size_t trow = t0 + 16 * mt + fr;
#pragma unroll
        for (int et = 0; et < 8; ++et) {
            const int e = 128 * eh + 16 * et + 4 * fq;
            const f32x4 g4 = *(const f32x4*)(gng + h * HV + e);
            const v2u r2 = *(const v2u*)(proj + trow * NP + C_R + h * HV + e);
            const float r[4] = {bflo(r2.x), bfhi(r2.x), bflo(r2.y), bfhi(r2.y)};
            float yv[4];
#pragma unroll
            for (int j = 0; j < 4; ++j) yv[j] = o[et][j] * rstd * g4[j] * (r[j] / (1.f + __expf(-r[j])));
            *(v2u*)(ymix + trow * D + DCONV + h * HV + e) = (v2u){pk2(yv[0], yv[1]), pk2(yv[2], yv[3])};
        }
        __syncthreads();
    }
}

template <bool WITH_BF16>
__device__ __forceinline__ void ln_phase(const Frame& F, float* X, const float* g, const float* bta, bf16* XB) {
    for (int m = F.gw; m < M; m += F.NGW) {
        f32x4* xr = (f32x4*)(X + (size_t)m * D) + F.lane;
        f32x4 v[8]; float s = 0.f;
#pragma unroll
        for (int j = 0; j < 8; ++j) { v[j] = xr[64 * j]; s += (v[j].x + v[j].y) + (v[j].z + v[j].w); }
        const float mean = wave_sum(s) * (1.f / D); float s2 = 0.f;
#pragma unroll
        for (int j = 0; j < 8; ++j) { v[j] = v[j] - mean; s2 += (v[j].x * v[j].x + v[j].y * v[j].y) + (v[j].z * v[j].z + v[j].w * v[j].w); }
        const float rstd = rsqrtf(wave_sum(s2) * (1.f / D) + LN_EPS);
#pragma unroll
        for (int j = 0; j < 8; ++j) { const f32x4 gg = *((const f32x4*)g + F.lane + 64 * j), bb = *((const f32x4*)bta + F.lane + 64 * j);
            const f32x4 y = v[j] * rstd * gg + bb; xr[64 * j] = y;
            if (WITH_BF16) *((v2u*)(XB + (size_t)m * D) + F.lane + 64 * j) = (v2u){pk2(y.x, y.y), pk2(y.z, y.w)}; }
    }
}

__global__ void __launch_bounds__(NTHREADS, 2) hymba_fwd(Args args) {
    extern __shared__ __attribute__((aligned(16))) unsigned char lds[];
    cg::grid_group grid = cg::this_grid();
    Frame F;
    F.lds = (LAS unsigned char*)lds;
    F.tid = threadIdx.x; F.lane = F.tid & 63; F.wave = __builtin_amdgcn_readfirstlane(F.tid >> 6);
    F.G = gridDim.x; F.gw = blockIdx.x * NWAVES + F.wave; F.NGW = F.G * NWAVES;
    unsigned char* ws = args.ws;
    bf16* proj = (bf16*)(ws + WS_PROJ); bf16* ymix = (bf16*)(ws + WS_YMIX); bf16* x1bf = (bf16*)(ws + WS_X1BF); bf16* hb = (bf16*)(ws + WS_H);

    volatile LAS unsigned* MISC = (volatile LAS unsigned*)(F.lds + MISC_OFF);
    if (F.tid < 64) MISC[F.tid] = 0u;
    __syncthreads();
    XcdBarrier bar = xcd_barrier_post((unsigned*)(ws + WS_BAR), MISC + 8);
    grid.sync();
#define GRID_SYNC() xcd_barrier(bar)
    p0_prologue(F, args);
    GRID_SYNC();
    {
        pg8::Gemm g{(const bf16*)(ws + WS_XBF), (const bf16*)(ws + WS_WIN), M, NP, D}; pg8::StaticOrder S; S.init(M, NP, F.G, (int)blockIdx.x);
        pg8::EpiBf16<0> E{proj, NP};
        pg8::gemm_phase<pg8::EpiBf16<0>, pg8::StaticOrder, PG8_ALIGN, PG8_SP2>(F.lds, g, S, E);
    }
    GRID_SYNC();
    p2a_gla(F, args);
    p2a_conv(F, args);
    GRID_SYNC();
    p2b_scan(F, args);
    GRID_SYNC();
    p2c_gla(F, args);
    GRID_SYNC();
    {
        pg8::Gemm g{ymix, (const bf16*)(ws + WS_WOUT), M, D, D}; pg8::StaticOrder S; S.init(M, D, F.G, (int)blockIdx.x);
        pg8::EpiResF32 E{args.in[0], args.out, D, DN_ALPHA};
        pg8::gemm_phase<pg8::EpiResF32, pg8::StaticOrder, PG8_ALIGN, PG8_SP2>(F.lds, g, S, E);
    }
    GRID_SYNC();
    ln_phase<true>(F, args.out, args.in[8], args.in[9], x1bf);
    GRID_SYNC();
    {
        pg8::Gemm g{x1bf, (const bf16*)(ws + WS_WUP), M, DFF, D}; pg8::StaticOrder S; S.init(M, DFF, F.G, (int)blockIdx.x);
        pg8::EpiBf16<1> E{hb, DFF};
        pg8::gemm_phase<pg8::EpiBf16<1>, pg8::StaticOrder, PG8_ALIGN, PG8_SP2>(F.lds, g, S, E);
    }
    GRID_SYNC();
    {
        pg8::Gemm g{hb, (const bf16*)(ws + WS_WDN), M, D, DFF}; pg8::StaticOrder S; S.init(M, D, F.G, (int)blockIdx.x);
        pg8::EpiResF32 E{args.out, args.out, D, DN_ALPHA};
        pg8::gemm_phase<pg8::EpiResF32, pg8::StaticOrder, PG8_ALIGN, PG8_SP2>(F.lds, g, S, E);
    }
    GRID_SYNC();
    ln_phase<false>(F, args.out, args.in[12], args.in[13], nullptr);
}

extern "C" void kernel_launch(void* const* d_in, const int* in_sizes, int n_in, void* d_out, int out_size, void* d_ws, size_t ws_size, hipStream_t stream) {
    static int grid = 0;
    if (grid == 0) {
        if (n_in != 14 || in_sizes[0] != M * D || out_size != M * D || ws_size < WS_END) { fprintf(stderr, "kernel_launch: unexpected shapes (n_in %d, in0 %d, out %d, ws %zu); nothing launched\n", n_in, n_in > 0 ? in_sizes[0] : -1, out_size, ws_size); grid = -1; return; }
        int dev = 0, cus = 0, per_cu = 0;
        if (hipGetDevice(&dev) != hipSuccess || hipDeviceGetAttribute(&cus, hipDeviceAttributeMultiprocessorCount, dev) != hipSuccess) { grid = -1; return; }
        if (hipFuncSetAttribute((const void*)hymba_fwd, hipFuncAttributeMaxDynamicSharedMemorySize, LDS_BYTES) != hipSuccess) { fprintf(stderr, "kernel_launch: hipFuncSetAttribute failed\n"); grid = -1; return; }
        if (hipOccupancyMaxActiveBlocksPerMultiprocessor(&per_cu, (const void*)hymba_fwd, NTHREADS, LDS_BYTES) != hipSuccess || per_cu < 1) { fprintf(stderr, "kernel_launch: occupancy query says %d blocks per CU\n", per_cu); per_cu = 1; }
        (void)hipGetLastError();
        grid = cus * per_cu;
    }
    if (grid < 0) return;
    if (hipMemsetAsync((char*)d_ws + WS_BAR, 0, BAR_BYTES, stream) != hipSuccess) { fprintf(stderr, "kernel_launch: hipMemsetAsync failed\n"); return; }
    Args a{};
    for (int i = 0; i < 14; ++i) a.in[i] = (const float*)d_in[i];
    a.out = (float*)d_out; a.ws = (unsigned char*)d_ws;
    void* kargs[] = {&a};
    const hipError_t e = hipLaunchCooperativeKernel((const void*)hymba_fwd, dim3(grid), dim3(NTHREADS), kargs, LDS_BYTES, stream);
    if (e != hipSuccess) fprintf(stderr, "kernel_launch: cooperative launch failed: %s (grid %d)\n", hipGetErrorString(e), grid);
}
```
